# Optimizing an MI355X kernel written in HIP

```python
import math
import jax, jax.numpy as jnp
from jax import lax
import numpy as np

D_MODEL = 1024
BATCH = 8
SEQ = 2048
DEPTH = 1
DEC_BATCH = 8
DEC_SEQ = 16
PAST_LEN = 4096

CHUNK = 64
A_HEADS = 4
A_DK = 128
A_DV = 128
A_WIDTH = A_HEADS * A_DV
CONV_W = 4
GDN_CHUNK = CHUNK
B_HEADS = 4
B_HD = 64
B_WIDTH = B_HEADS * B_HD
IDX_HEADS = 8
IDX_HD = 32
IDX_SCALE = (IDX_HEADS ** -0.5) * (IDX_HD ** -0.5)
TOPK_MAX = 256
Q_BLOCK = 128
N_MEM = 256
M_HEADS = 4
M_HD = 64
M_WIDTH = M_HEADS * M_HD
D_MIX = A_WIDTH + B_WIDTH + M_WIDTH
EPS = 1e-6
IN_SPLITS = (3 * A_WIDTH, A_WIDTH, A_HEADS, A_HEADS,
             B_WIDTH, B_WIDTH, B_WIDTH, B_WIDTH, IDX_HEADS * IDX_HD, IDX_HD, IDX_HEADS,
             M_WIDTH, M_WIDTH)
IN_WIDTH = sum(IN_SPLITS)

kernel_name = 'hybrid_gdn_dsa_mem_stream_step'


def rms_norm(x, g):
    xf = x.astype(jnp.float32)
    y = xf * lax.rsqrt(jnp.mean(xf * xf, axis=-1, keepdims=True) + EPS)
    return (y * g.astype(jnp.float32)).astype(x.dtype)


def l2_norm(x):
    return x * lax.rsqrt(jnp.sum(x * x, axis=-1, keepdims=True) + EPS)


def split_cols(p):
    offs = [int(o) for o in np.cumsum(IN_SPLITS)[:-1]]
    return jnp.split(p, offs, axis=-1)


def causal_conv(buf, x, w):
    xp = jnp.concatenate([buf.astype(x.dtype), x], axis=1)
    t_len = x.shape[1]
    y = xp[:, 0:t_len] * w[0]
    for j in range(1, CONV_W):
        y = y + xp[:, j:j + t_len] * w[j]
    return jax.nn.silu(y), xp[:, -(CONV_W - 1):]


def gated_delta(q, k, v, g, beta, s0, chunk):
    bsz, t_len, nh, dk = q.shape
    dv = v.shape[-1]
    n = t_len // chunk

    def blk(t):
        return jnp.moveaxis(t.reshape(bsz, n, chunk, nh, *t.shape[3:]), 3, 2)

    q, k, v, g, beta = blk(q), blk(k), blk(v), blk(g), blk(beta)
    gc = jnp.cumsum(g, axis=-1)
    tri = jnp.tril(jnp.ones((chunk, chunk), bool))
    strict = tri & ~jnp.eye(chunk, dtype=bool)
    diff = gc[..., :, None] - gc[..., None, :]
    decay = jnp.where(tri, jnp.exp(jnp.where(tri, diff, 0.0)), 0.0)
    kb = k * beta[..., None]
    lmat = jnp.where(strict, jnp.einsum('bnhid,bnhjd->bnhij', kb, k) * decay, 0.0)
    amat = lmat + jnp.eye(chunk, dtype=jnp.float32)
    rhs = jnp.concatenate([v * beta[..., None], kb * jnp.exp(gc)[..., None]], axis=-1)
    sol = lax.linalg.triangular_solve(amat, rhs, left_side=True, lower=True)
    u0, wk = sol[..., :dv], sol[..., dv:]
    qk = jnp.einsum('bnhid,bnhjd->bnhij', q, k) * decay
    q_dec = q * jnp.exp(gc)[..., None]
    k_dec = k * jnp.exp(gc[..., -1:] - gc)[..., None]
    last = jnp.exp(gc[..., -1])

    def step(s, xs):
        qk_c, qd_c, kd_c, u0_c, w_c, last_c = xs
        u = u0_c - jnp.einsum('bhcd,bhde->bhce', w_c, s)
        o = jnp.einsum('bhcd,bhde->bhce', qd_c, s) + jnp.einsum('bhij,bhje->bhie', qk_c, u)
        s = s * last_c[..., None, None] + jnp.einsum('bhcd,bhce->bhde', kd_c, u)
        return s, o

    xs = tuple(jnp.moveaxis(t, 1, 0) for t in (qk, q_dec, k_dec, u0, wk, last))
    s_fin, o = lax.scan(step, s0, xs)
    o = jnp.transpose(o, (1, 0, 3, 2, 4)).reshape(bsz, t_len, nh, dv)
    return o, s_fin


def sparse_block(q, qi, wi, q_pos, k, v, ki, k_pos, n_sel):
    f32 = jnp.float32
    adm = (k_pos[None, :] // CHUNK) <= (q_pos[:, None] // CHUNK)
    logits = jnp.einsum('bqhd,bsd->bqhs', qi.astype(f32), ki.astype(f32))
    score = jnp.einsum('bqh,bqhs->bqs', wi.astype(f32), jax.nn.relu(logits))
    score = jnp.where(adm[None], score, -jnp.inf)
    _, idx = lax.top_k(score, n_sel)
    valid = (k_pos[idx] // CHUNK) <= (q_pos[None, :, None] // CHUNK)
    ks = jax.vmap(lambda a, i: a[i])(k, idx)
    vs = jax.vmap(lambda a, i: a[i])(v, idx)
    s = jnp.einsum('bqhd,bqkhd->bqhk', q.astype(f32), ks.astype(f32)) * (B_HD ** -0.5)
    s = jnp.where(valid[:, :, None, :], s, -jnp.inf)
    p = jax.nn.softmax(s, axis=-1)
    return jnp.einsum('bqhk,bqkhd->bqhd', p, vs.astype(f32))


def sparse_attention(q, qi, wi, q_pos, k, v, ki, k_pos, n_sel):
    bsz, t_len = q.shape[0], q.shape[1]
    if t_len <= Q_BLOCK:
        return sparse_block(q, qi, wi, q_pos, k, v, ki, k_pos, n_sel)
    nb = t_len // Q_BLOCK

    def blocks(t):
        return jnp.moveaxis(t.reshape(bsz, nb, Q_BLOCK, *t.shape[2:]), 1, 0)

    xs = (blocks(q), blocks(qi), blocks(wi), q_pos.reshape(nb, Q_BLOCK))
    o = lax.map(lambda a: sparse_block(a[0], a[1], a[2], a[3], k, v, ki, k_pos, n_sel), xs)
    return jnp.moveaxis(o, 0, 1).reshape(bsz, t_len, *o.shape[3:])


def memory_kv(mem, g_mem, w_mem_kv, g_km):
    bsz = mem.shape[0]
    m = rms_norm(mem, g_mem) @ w_mem_kv
    mk, mv = jnp.split(m, 2, axis=-1)
    mk = rms_norm(mk.reshape(bsz, N_MEM, M_HEADS, M_HD), g_km)
    mv = mv.reshape(bsz, N_MEM, M_HEADS, M_HD)
    return mk, mv


def layer(x, mem_k, mem_v, conv_buf, s0, past_k, past_v, past_ki, gdn_chunk,
          g_in, w_in, conv_w, a_log, dt_bias, g_o, g_qb, g_kb, g_ki, g_qm, w_out):
    f32 = jnp.float32
    bsz, t_len, _ = x.shape
    p_len = past_k.shape[1]
    h = rms_norm(x, g_in)
    (qkv_a, z_a, b_a, a_a, q_b, k_b, v_b, z_b, q_i, k_i, w_i, q_m, z_m) = split_cols(h @ w_in)

    conv_out, conv_new = causal_conv(conv_buf, qkv_a, conv_w)
    q_a, k_a, v_a = jnp.split(conv_out.astype(f32), 3, axis=-1)
    q_a = l2_norm(q_a.reshape(bsz, t_len, A_HEADS, A_DK)) * (A_DK ** -0.5)
    k_a = l2_norm(k_a.reshape(bsz, t_len, A_HEADS, A_DK))
    v_a = v_a.reshape(bsz, t_len, A_HEADS, A_DV)
    beta = jax.nn.sigmoid(b_a.astype(f32))
    g_log = -jnp.exp(a_log.astype(f32)) * jax.nn.softplus(a_a.astype(f32) + dt_bias.astype(f32))
    o_a, s_new = gated_delta(q_a, k_a, v_a, g_log, beta, s0.astype(f32), gdn_chunk)
    o_a = rms_norm(o_a, g_o) * jax.nn.silu(z_a.astype(f32).reshape(bsz, t_len, A_HEADS, A_DV))
    o_a = o_a.reshape(bsz, t_len, A_WIDTH)

    q_b = rms_norm(q_b.reshape(bsz, t_len, B_HEADS, B_HD), g_qb)
    k_b = rms_norm(k_b.reshape(bsz, t_len, B_HEADS, B_HD), g_kb)
    v_b = v_b.reshape(bsz, t_len, B_HEADS, B_HD)
    k_i = rms_norm(k_i, g_ki)
    q_i = q_i.reshape(bsz, t_len, IDX_HEADS, IDX_HD)
    w_i = w_i * IDX_SCALE
    k_all = jnp.concatenate([past_k.astype(k_b.dtype), k_b], axis=1)
    v_all = jnp.concatenate([past_v.astype(v_b.dtype), v_b], axis=1)
    ki_all = jnp.concatenate([past_ki.astype(k_i.dtype), k_i], axis=1)
    q_pos = p_len + jnp.arange(t_len, dtype=jnp.int32)
    k_pos = jnp.arange(p_len + t_len, dtype=jnp.int32)
    n_sel = min(TOPK_MAX, (p_len + t_len) // 4)
    o_b = sparse_attention(q_b, q_i, w_i, q_pos, k_all, v_all, ki_all, k_pos, n_sel)
    o_b = o_b.reshape(bsz, t_len, B_WIDTH) * jax.nn.silu(z_b.astype(f32))

    q_m = rms_norm(q_m.reshape(bsz, t_len, M_HEADS, M_HD), g_qm).astype(f32)
    s_m = jnp.einsum('bqhd,bmhd->bhqm', q_m, mem_k.astype(f32)) * (M_HD ** -0.5)
    o_m = jnp.einsum('bhqm,bmhd->bqhd', jax.nn.softmax(s_m, axis=-1), mem_v.astype(f32))
    o_m = o_m.reshape(bsz, t_len, M_WIDTH) * jax.nn.silu(z_m.astype(f32))

    mix = jnp.concatenate([o_a, o_b, o_m], axis=-1).astype(x.dtype)
    y = x + mix @ w_out
    return y, conv_new, s_new.astype(x.dtype), k_b, v_b, k_i


def setup_inputs(seed: int = 0) -> dict:
    key = jax.random.key(seed)
    ks = jax.random.split(key, 32)
    f32 = jnp.float32

    def nrm(k, shape, scale=1.0):
        return jax.random.normal(k, shape, f32) * scale

    def gain(k, shape):
        return 1.0 + 0.02 * jax.random.normal(k, shape, f32)

    dt = jnp.exp(jax.random.uniform(ks[14], (DEPTH, A_HEADS), f32, math.log(1e-3), math.log(1e-1)))
    return {
        'x_prompt': nrm(ks[0], (BATCH, SEQ, D_MODEL)),
        'x_sample': nrm(ks[1], (DEC_BATCH, DEC_SEQ, D_MODEL)),
        'state_conv_A': nrm(ks[2], (DEPTH, DEC_BATCH, CONV_W - 1, 3 * A_WIDTH)),
        'state_ssm_A': nrm(ks[3], (DEPTH, DEC_BATCH, A_HEADS, A_DK, A_DV), 0.1),
        'cache_k_B': nrm(ks[4], (DEPTH, DEC_BATCH, PAST_LEN, B_HEADS, B_HD)),
        'cache_v_B': nrm(ks[5], (DEPTH, DEC_BATCH, PAST_LEN, B_HEADS, B_HD)),
        'cache_kidx_B': nrm(ks[6], (DEPTH, DEC_BATCH, PAST_LEN, IDX_HD)),
        'cache_mem_k': nrm(ks[7], (DEPTH, DEC_BATCH, N_MEM, M_HEADS, M_HD)),
        'cache_mem_v': nrm(ks[8], (DEPTH, DEC_BATCH, N_MEM, M_HEADS, M_HD)),
        'mem_prompt': nrm(ks[9], (BATCH, N_MEM, D_MODEL)),
        'g_in': gain(ks[10], (DEPTH, D_MODEL)),
        'w_in': nrm(ks[11], (DEPTH, D_MODEL, IN_WIDTH), D_MODEL ** -0.5),
        'conv_w_A': nrm(ks[12], (DEPTH, CONV_W, 3 * A_WIDTH), CONV_W ** -0.5),
        'a_log_A': jnp.log(jax.random.uniform(ks[13], (DEPTH, A_HEADS), f32, 1.0, 16.0)),
        'dt_bias_A': dt + jnp.log(-jnp.expm1(-dt)),
        'g_o_A': gain(ks[15], (DEPTH, A_DV)),
        'g_q_B': gain(ks[16], (DEPTH, B_HD)),
        'g_k_B': gain(ks[17], (DEPTH, B_HD)),
        'g_kidx_B': gain(ks[18], (DEPTH, IDX_HD)),
        'g_mem': gain(ks[19], (DEPTH, D_MODEL)),
        'w_mem_kv': nrm(ks[20], (DEPTH, D_MODEL, 2 * M_WIDTH), D_MODEL ** -0.5),
        'g_q_M': gain(ks[21], (DEPTH, M_HD)),
        'g_k_M': gain(ks[22], (DEPTH, M_HD)),
        'w_out': nrm(ks[23], (DEPTH, D_MIX, D_MODEL), D_MIX ** -0.5),
    }


def reference(x_prompt, x_sample, state_conv_A, state_ssm_A, cache_k_B, cache_v_B, cache_kidx_B,
              cache_mem_k, cache_mem_v, mem_prompt, g_in, w_in, conv_w_A, a_log_A, dt_bias_A, g_o_A,
              g_q_B, g_k_B, g_kidx_B, g_mem, w_mem_kv, g_q_M, g_k_M, w_out):
    bp = x_prompt.shape[0]
    dt_ = x_prompt.dtype
    zero_conv = jnp.zeros((bp, CONV_W - 1, 3 * A_WIDTH), dt_)
    zero_ssm = jnp.zeros((bp, A_HEADS, A_DK, A_DV), jnp.float32)
    empty_k = jnp.zeros((bp, 0, B_HEADS, B_HD), dt_)
    empty_ki = jnp.zeros((bp, 0, IDX_HD), dt_)
    yp, ys = x_prompt, x_sample
    pc, pS, pk, pv, pki, pmk, pmv = [], [], [], [], [], [], []
    sc, sS, sk, sv, ski = [], [], [], [], []
    for l in range(DEPTH):
        wts = (g_in[l], w_in[l], conv_w_A[l], a_log_A[l], dt_bias_A[l], g_o_A[l],
               g_q_B[l], g_k_B[l], g_kidx_B[l], g_q_M[l], w_out[l])
        mk, mv = memory_kv(mem_prompt, g_mem[l], w_mem_kv[l], g_k_M[l])
        yp, c1, s1, k1, v1, ki1 = layer(yp, mk, mv, zero_conv, zero_ssm, empty_k, empty_k, empty_ki,
                                        GDN_CHUNK, *wts)
        ys, c2, s2, k2, v2, ki2 = layer(ys, cache_mem_k[l], cache_mem_v[l], state_conv_A[l], state_ssm_A[l],
                                        cache_k_B[l], cache_v_B[l], cache_kidx_B[l], ys.shape[1], *wts)
        pc.append(c1); pS.append(s1); pk.append(k1); pv.append(v1); pki.append(ki1)
        pmk.append(mk); pmv.append(mv)
        sc.append(c2); sS.append(s2); sk.append(k2); sv.append(v2); ski.append(ki2)
    p_conv_A = jnp.stack(pc)
    p_ssm_A = jnp.stack(pS)
    p_k_B = jnp.stack(pk)
    p_v_B = jnp.stack(pv)
    p_kidx_B = jnp.stack(pki)
    p_mem_k = jnp.stack(pmk)
    p_mem_v = jnp.stack(pmv)
    s_conv_A = jnp.stack(sc)
    s_ssm_A = jnp.stack(sS)
    s_k_B = jnp.stack(sk)
    s_v_B = jnp.stack(sv)
    s_kidx_B = jnp.stack(ski)
    return (yp, ys, p_conv_A, p_ssm_A, p_k_B, p_v_B, p_kidx_B, p_mem_k, p_mem_v,
            s_conv_A, s_ssm_A, s_k_B, s_v_B, s_kidx_B)
```

```cpp
#include <hip/hip_runtime.h>
#include <cstdio>
#include <cstdint>
namespace pg8 {
#define PG8_LAS __attribute__((address_space(3)))
typedef unsigned short bf16_t;
typedef short bf16x8 __attribute__((ext_vector_type(8)));
typedef float f32x4 __attribute__((ext_vector_type(4)));
typedef unsigned u32x4 __attribute__((ext_vector_type(4)));
constexpr int BM = 256, BK = 64, HALF = 128, HTB = HALF * BK * 2  , STAGE_BYTES = 8 * HTB, NXCD = 8, WGM = 8;

__host__ __device__ __forceinline__ int lds_byte(int r, int c) { const int st = (r >> 4) * 2 + (c >> 5), rr = r & 15, cc = c & 31, ob = rr * 64 + cc * 2; return st * 1024 + (ob ^ (((ob >> 9) & 1) << 5)); }
__host__ __device__ __forceinline__ void stage_rc(int b, int& R, int& C) { const int st = b / 1024, sb = b % 1024, swz = sb ^ (((sb >> 9) & 1) << 5); R = (st >> 1) * 16 + swz / 64; C = (st & 1) * 32 + (swz % 64) / 2; }
__host__ __device__ __forceinline__ int perm32(int rho) { const int n = rho >> 4, i = rho & 15; return 8 * (i >> 2) + 4 * n + (i & 3); }

struct Unit { int pm, pn; };
struct Gemm { const bf16_t* A; const bf16_t* Bt; int M, N, K; };

struct StaticOrder {
    int nM, nN, nwg, G, c;
    __host__ __device__ void init(int M, int N, int G_, int c_) { nM = M / BM; nN = N / BM; nwg = nM * nN; G = G_; c = c_; }
    __host__ __device__ bool next(int i, Unit& u) const {
        const long L = (long)i * G + c; if (L >= nwg) return false;
        int wgid = (int)L; { const int q = nwg / NXCD, r = nwg % NXCD, xcd = wgid % NXCD, off = wgid / NXCD; wgid = (xcd < r ? xcd * (q + 1) : r * (q + 1) + (xcd - r) * q) + off; }
        const int nig = WGM * nN, gid = wgid / nig, fm = gid * WGM, gsz = (nM - fm) < WGM ? (nM - fm) : WGM;
        u.pm = fm + ((wgid % nig) % gsz); u.pn = (wgid % nig) / gsz; return true;
    }
    __device__ __forceinline__ void a_ready(const Unit&) const {}
    __device__ __forceinline__ void done(const Unit&) const {}
};

__device__ __forceinline__ unsigned cvt_pk_bf16(float lo, float hi) { unsigned r; asm volatile("v_cvt_pk_bf16_f32 %0, %1, %2" : "=v"(r) : "v"(lo), "v"(hi)); return r; }

template <class Epi, class Sched, bool ALIGN_EPI = false, bool SP2 = false>
__device__ __forceinline__ void gemm_phase(PG8_LAS unsigned char* lds, const Gemm g, const Sched& S, const Epi& E) {
    const int tid = threadIdx.x, wid = __builtin_amdgcn_readfirstlane(tid >> 6), lane = tid & 63, wr = wid >> 2, wc = wid & 3, fr = lane & 15, fq = lane >> 4;
    const int K = g.K, nt = K / BK;
    unsigned voffA[2], voffB[2];
#pragma unroll
    for (int i = 0; i < 2; ++i) { int R, C; stage_rc(tid * 16 + i * 8192, R, C); const int Rb = Epi::PERM ? ((R & ~31) + perm32(R & 31)) : R;
        voffA[i] = (unsigned)(R * K + C) * 2u; voffB[i] = (unsigned)(Rb * K + C) * 2u; }
    const size_t kstep = (size_t)(BK * 2);
    const size_t hstep = (size_t)HALF * K * 2;
    const size_t tstep = 2 * hstep;
    const unsigned ldsw = (unsigned)wid * 1024u;
    const int aoff = lds_byte(wr * 64 + fr, fq * 8), boff = lds_byte(wc * 32 + fr, fq * 8);
#define PG8_SA(b, h) (((b) * 2 + (h)) * HTB)
#define PG8_SB(b, h) ((4 + (b) * 2 + (h)) * HTB)
#define PG8_STAGE(bufoff, gbase, voff) do { _Pragma("unroll") for (int _i = 0; _i < 2; ++_i) \
        __builtin_amdgcn_global_load_lds((const unsigned*)((const char*)(gbase) + (voff)[_i]), (PG8_LAS unsigned*)(lds + (bufoff) + ldsw + _i * 8192), 16, 0, 0); } while (0)
#define PG8_LDA(dst, b, h) do { _Pragma("unroll") for (int m = 0; m < 4; ++m) _Pragma("unroll") for (int k = 0; k < 2; ++k) dst[m][k] = *(const PG8_LAS bf16x8*)(lds + PG8_SA(b, h) + aoff + m * 2048 + k * 1024); } while (0)
#define PG8_LDB(dst, b, h) do { _Pragma("unroll") for (int n = 0; n < 2; ++n) _Pragma("unroll") for (int k = 0; k < 2; ++k) dst[n][k] = *(const PG8_LAS bf16x8*)(lds + PG8_SB(b, h) + boff + n * 2048 + k * 1024); } while (0)
#define PG8_MMA(ai, bj, At, Bt) do { __builtin_amdgcn_s_setprio(1); _Pragma("unroll") for (int m = 0; m < 4; ++m) _Pragma("unroll") for (int n = 0; n < 2; ++n) _Pragma("unroll") for (int k = 0; k < 2; ++k) \
        acc[ai][bj][m][n] = __builtin_amdgcn_mfma_f32_16x16x32_bf16(Bt[n][k], At[m][k], acc[ai][bj][m][n], 0, 0, 0); __builtin_amdgcn_s_setprio(0); } while (0)
#define PG8_WAIT_V(n) asm volatile("s_waitcnt vmcnt(" #n ")" ::: "memory")
#define PG8_WAIT_L(n) asm volatile("s_waitcnt lgkmcnt(" #n ")" ::: "memory")
#define PG8_BAR __builtin_amdgcn_s_barrier()
#define PG8_SCHED __builtin_amdgcn_sched_barrier(0)
    Unit cur, nxt; int ui = 0;
    if (!S.next(0, cur)) return;
    f32x4 acc[2][2][4][2];
#pragma unroll
    for (int a = 0; a < 2; ++a)
#pragma unroll
        for (int b = 0; b < 2; ++b)
#pragma unroll
            for (int m = 0; m < 4; ++m)
#pragma unroll
                for (int n = 0; n < 2; ++n) acc[a][b][m][n] = (f32x4){0.f, 0.f, 0.f, 0.f};
    bf16x8 At[4][2], B0[2][2], B1[2][2];
    const char* cA = (const char*)g.A + (size_t)cur.pm * tstep; const char* cB = (const char*)g.Bt + (size_t)cur.pn * tstep;
    S.a_ready(cur);
    if constexpr (SP2) {
        PG8_STAGE(PG8_SB(0, 0), cB, voffB); PG8_STAGE(PG8_SB(0, 1), cB + hstep, voffB); PG8_STAGE(PG8_SA(0, 0), cA, voffA); PG8_STAGE(PG8_SA(0, 1), cA + hstep, voffA);
        if (wr == 1) PG8_BAR;
        PG8_WAIT_V(2); PG8_BAR;
        PG8_STAGE(PG8_SB(1, 0), cB + kstep, voffB); PG8_STAGE(PG8_SA(1, 0), cA + kstep, voffA); PG8_STAGE(PG8_SB(1, 1), cB + hstep + kstep, voffB);
        PG8_WAIT_V(6); PG8_BAR;
    } else {
        PG8_STAGE(PG8_SB(0, 0), cB, voffB); PG8_STAGE(PG8_SA(0, 0), cA, voffA); PG8_STAGE(PG8_SB(0, 1), cB + hstep, voffB); PG8_STAGE(PG8_SA(0, 1), cA + hstep, voffA);
        if (wr == 1) PG8_BAR;
        PG8_WAIT_V(4); PG8_BAR;
        PG8_STAGE(PG8_SB(1, 0), cB + kstep, voffB); PG8_STAGE(PG8_SA(1, 0), cA + kstep, voffA); PG8_STAGE(PG8_SB(1, 1), cB + hstep + kstep, voffB);
        PG8_WAIT_V(6); PG8_BAR;
    }
    for (;;) {
        const bool has_next = S.next(ui + 1, nxt);
        const char* nA = has_next ? (const char*)g.A + (size_t)nxt.pm * tstep : cA; const char* nB = has_next ? (const char*)g.Bt + (size_t)nxt.pn * tstep : cB;
        for (int t = 0; t < nt; t += 2) {
            const bool last = (t == nt - 2);
            const char* a1 = cA + (size_t)(t + 1) * kstep;
            const char* a2 = last ? nA : cA + (size_t)(t + 2) * kstep; const char* b2 = last ? nB : cB + (size_t)(t + 2) * kstep;
            const char* a3 = a2 + kstep; const char* b3 = b2 + kstep;
            if (last && has_next) S.a_ready(nxt);
            if constexpr (SP2) {
            PG8_LDB(B0, 0, 0); PG8_LDB(B1, 0, 1); PG8_SCHED; PG8_LDA(At, 0, 0); PG8_STAGE(PG8_SA(1, 1), a1 + hstep, voffA);
            PG8_WAIT_V(8); PG8_WAIT_L(0); PG8_BAR; PG8_MMA(0, 0, At, B0); PG8_MMA(0, 1, At, B1); PG8_BAR; PG8_SCHED;
            PG8_LDA(At, 0, 1); PG8_STAGE(PG8_SB(0, 0), b2, voffB); PG8_STAGE(PG8_SB(0, 1), b2 + hstep, voffB); PG8_STAGE(PG8_SA(0, 0), a2, voffA);
            PG8_WAIT_V(8); PG8_WAIT_L(0); PG8_BAR; PG8_MMA(1, 0, At, B0); PG8_MMA(1, 1, At, B1); PG8_BAR; PG8_SCHED;
            PG8_LDB(B0, 1, 0); PG8_LDB(B1, 1, 1); PG8_SCHED; PG8_LDA(At, 1, 0); PG8_STAGE(PG8_SA(0, 1), a2 + hstep, voffA);
            PG8_WAIT_V(8); PG8_WAIT_L(0); PG8_BAR; PG8_MMA(0, 0, At, B0); PG8_MMA(0, 1, At, B1); PG8_BAR; PG8_SCHED;
            PG8_LDA(At, 1, 1); PG8_STAGE(PG8_SB(1, 0), b3, voffB); PG8_STAGE(PG8_SB(1, 1), b3 + hstep, voffB); PG8_STAGE(PG8_SA(1, 0), a3, voffA);
            PG8_WAIT_V(8); PG8_WAIT_L(0); PG8_BAR; PG8_MMA(1, 0, At, B0); PG8_MMA(1, 1, At, B1); PG8_BAR; PG8_SCHED;
            } else {
            PG8_LDB(B0, 0, 0); PG8_SCHED; PG8_LDA(At, 0, 0); PG8_STAGE(PG8_SA(1, 1), a1 + hstep, voffA);
            PG8_WAIT_L(8); PG8_BAR; PG8_WAIT_L(0); PG8_MMA(0, 0, At, B0); PG8_BAR; PG8_SCHED;
            PG8_LDB(B1, 0, 1); PG8_STAGE(PG8_SB(0, 0), b2, voffB);
            PG8_BAR; PG8_WAIT_L(0); PG8_MMA(0, 1, At, B1); PG8_BAR;
            PG8_LDA(At, 0, 1); PG8_STAGE(PG8_SA(0, 0), a2, voffA);
            PG8_BAR; PG8_WAIT_L(0); PG8_MMA(1, 0, At, B0); PG8_BAR; PG8_SCHED;
            PG8_STAGE(PG8_SB(0, 1), b2 + hstep, voffB);
            PG8_WAIT_V(6); PG8_BAR; PG8_MMA(1, 1, At, B1); PG8_BAR;
            PG8_LDB(B0, 1, 0); PG8_SCHED; PG8_LDA(At, 1, 0); PG8_STAGE(PG8_SA(0, 1), a2 + hstep, voffA);
            PG8_WAIT_L(8); PG8_BAR; PG8_WAIT_L(0); PG8_MMA(0, 0, At, B0); PG8_BAR; PG8_SCHED;
            PG8_LDB(B1, 1, 1); PG8_STAGE(PG8_SB(1, 0), b3, voffB);
            PG8_BAR; PG8_WAIT_L(0); PG8_MMA(0, 1, At, B1); PG8_BAR;
            PG8_LDA(At, 1, 1); PG8_STAGE(PG8_SA(1, 0), a3, voffA);
            PG8_BAR; PG8_WAIT_L(0); PG8_MMA(1, 0, At, B0); PG8_BAR; PG8_SCHED;
            PG8_STAGE(PG8_SB(1, 1), b3 + hstep, voffB);
            PG8_WAIT_V(6); PG8_BAR; PG8_MMA(1, 1, At, B1); PG8_BAR;
            }
        }
        if constexpr (ALIGN_EPI) { if (wr == 0) PG8_BAR; }
        if constexpr (!Epi::AFTER_DRAIN) { E(acc, cur, wr, wc, fr, fq);
            S.done(cur); }
        if (!has_next) break;
#pragma unroll
        for (int a = 0; a < 2; ++a)
#pragma unroll
            for (int b = 0; b < 2; ++b)
#pragma unroll
                for (int m = 0; m < 4; ++m)
#pragma unroll
                    for (int n = 0; n < 2; ++n) acc[a][b][m][n] = (f32x4){0.f, 0.f, 0.f, 0.f};
        cur = nxt; cA = nA; cB = nB; ++ui;
        if constexpr (ALIGN_EPI) { if (wr == 1) PG8_BAR; }
    }
    PG8_WAIT_V(0);
    if constexpr (!ALIGN_EPI) { if (wr == 0) PG8_BAR; }
    PG8_BAR;
    if constexpr (Epi::AFTER_DRAIN) { E.fused(acc, cur, wr, wc, fr, fq, lds, wid, lane); S.done(cur); }
#undef PG8_SA
#undef PG8_SB
#undef PG8_STAGE
#undef PG8_LDA
#undef PG8_LDB
#undef PG8_MMA
#undef PG8_WAIT_V
#undef PG8_WAIT_L
#undef PG8_BAR
#undef PG8_SCHED
}
}

constexpr int DM = 1024, NB = 8, T = 2048, ST = 16, PAST = 4096;
constexpr int MP = NB * T;
constexpr int MS = NB * ST;
constexpr int MTOK = MP + MS;
constexpr int MPAD = 16640;
constexpr int NIN = 4096;
constexpr int NMEMTOK = NB * 256;
constexpr int WIN = 3888;
constexpr float EPS = 1e-6f;
constexpr float IDX_SCALE = 0.0625f;
constexpr int NWAVES = 8;
#ifndef MK_N_LAUNCHES
#define MK_N_LAUNCHES 1
#endif
constexpr int N_LAUNCHES = MK_N_LAUNCHES;
constexpr int PER_PHASE = 6;

constexpr size_t OFF_YP = 0, OFF_YS = 16777216, OFF_PCONV = 16908288, OFF_PSSM = 16945152, OFF_PK = 17469440, OFF_PV = 21663744,
                 OFF_PKI = 25858048, OFF_PMK = 26382336, OFF_PMV = 26906624, OFF_SCONV = 27430912, OFF_SSSM = 27467776,
                 OFF_SK = 27992064, OFF_SV = 28024832, OFF_SKI = 28057600, OUT_TOTAL = 28061696;

constexpr size_t MiB = 1u << 20;
constexpr size_t WS_CTL = 0, CTL_ZERO_BYTES = 96 * 1024;
constexpr size_t WS_WOUT = 1 * MiB;
constexpr size_t WS_WIN = 3 * MiB;
constexpr size_t WS_XN = 12 * MiB;
constexpr int MALL = MPAD + 2048, NALL = NIN + 512;
constexpr size_t WS_MIX = WS_XN;
constexpr size_t WS_QKVA = 49 * MiB;
constexpr size_t WS_OA = WS_QKVA;
constexpr size_t WS_ZA = 98 * MiB;
constexpr size_t ROWBUF = (size_t)MPAD * 256 * 2;
constexpr size_t WS_QB = 115 * MiB;
constexpr size_t WS_KB = WS_QB + ROWBUF, WS_VB = WS_KB + ROWBUF, WS_ZB = WS_VB + ROWBUF, WS_QI = WS_ZB + ROWBUF, WS_QM = WS_QI + ROWBUF, WS_ZM = WS_QM + ROWBUF;
constexpr size_t WS_SMALL = 172 * MiB;
constexpr size_t WS_KI = WS_SMALL + (size_t)MPAD * 64 + 65536;
constexpr size_t WS_MEMK = 175 * MiB, WS_MEMV = 176 * MiB;
constexpr int NGITEM = 1056;
constexpr size_t WS_GWK = 177 * MiB;
constexpr size_t GBIG = (size_t)NGITEM * 64 * 128 * 2;
constexpr size_t WS_GQD = WS_GWK + GBIG, WS_GKDT = WS_GQD + GBIG, WS_GU0 = WS_GKDT + GBIG, WS_GQK = WS_GU0 + GBIG;
constexpr size_t WS_GLAST = WS_GQK + GBIG / 2;
constexpr size_t WS_SLIST = 251 * MiB + 512 * 1024;
constexpr size_t WS_SELW = 252 * MiB;
constexpr size_t WS_END = WS_SELW + (size_t)MP * 256;
static_assert(WS_GLAST + 8192 <= WS_SLIST && WS_SLIST + 128 * 256 * 4 <= WS_SELW, "ws map 2");
static_assert(WS_ZM + ROWBUF <= WS_SMALL && WS_KI + (size_t)MPAD * 64 <= WS_MEMK && WS_XN + (size_t)MALL * 2048 <= WS_QKVA && WS_WIN + (size_t)NALL * 2048 <= WS_XN && WS_QKVA + (size_t)MPAD * 3072 <= WS_ZA && WS_ZA + (size_t)MPAD * 1024 <= WS_QB && WS_END <= 256 * MiB, "ws map");

constexpr int CW_TMO = 0, CW_CODE = 1;
constexpr int CW_Q0 = 64, CW_Q1 = 128, CW_Q2 = 192;
constexpr int CW_BAR = 4096;
constexpr int CW_GATE = 16384;

constexpr int LDS_BYTES = 163840;
constexpr int LDS_MAIN = 0;
constexpr int LDS_X = 131072;
constexpr int LDSCTL_OFF = 163840 - 512;
constexpr int MISC_OFF = LDSCTL_OFF;

#define GAS __attribute__((address_space(1)))
#define LAS __attribute__((address_space(3)))
typedef unsigned short bf16;
typedef unsigned v4u __attribute__((ext_vector_type(4)));
typedef unsigned v2u __attribute__((ext_vector_type(2)));
typedef float f32x4 __attribute__((ext_vector_type(4)));
typedef short bf16x8 __attribute__((ext_vector_type(8)));
typedef short s16x4 __attribute__((ext_vector_type(4)));
typedef GAS unsigned gu32;
#define RLX_AGENT __ATOMIC_RELAXED, __HIP_MEMORY_SCOPE_AGENT
#define LDS_WAIT() asm volatile("s_waitcnt lgkmcnt(0)" ::: "memory")
#define VM_WAIT() asm volatile("s_waitcnt vmcnt(0)" ::: "memory")
__device__ __forceinline__ unsigned f2bf(float f) { unsigned u = __builtin_bit_cast(unsigned, f); return (u + 0x7fffu + ((u >> 16) & 1u)) >> 16; }
typedef float f32x2_t __attribute__((ext_vector_type(2))); typedef __bf16 bf16x2_t __attribute__((ext_vector_type(2)));
__device__ __forceinline__ unsigned pk2(float lo, float hi) { const f32x2_t v = {lo, hi}; const bf16x2_t b = __builtin_convertvector(v, bf16x2_t); return __builtin_bit_cast(unsigned, b); }
__device__ __forceinline__ float bf2f(unsigned short b) { return __builtin_bit_cast(float, ((unsigned)b) << 16); }
__device__ __forceinline__ float bflo(unsigned w) { return __builtin_bit_cast(float, w << 16); }
__device__ __forceinline__ float bfhi(unsigned w) { return __builtin_bit_cast(float, w & 0xffff0000u); }
__device__ __forceinline__ float fexp2(float x) { return __builtin_amdgcn_exp2f(x); }
__device__ __forceinline__ float frcp(float x) { return __builtin_amdgcn_rcpf(x); }
__device__ __forceinline__ float silu_f(float x) { return x * frcp(1.0f + fexp2(-1.4426950408889634f * x)); }
__device__ __forceinline__ float wave_sum(float v) {
#pragma unroll
    for (int o = 1; o < 64; o <<= 1) v += __shfl_xor(v, o);
    return v;
}

#define XB_TMO      128
#define XB_XCNT(j)  (256  + 64 * (j))
#define XB_XSUB(j)  (1280 + 64 * (j))
#define XB_XGEN(j)  (2304 + 64 * (j))
#define XB_TOP      3328
#define XB_TOPGEN   3392
#define XCD_BAR_WORDS 3456
#define XB_SPIN_CAP (1u << 20)
__device__ __forceinline__ unsigned xb_ld(unsigned* p)              { return __hip_atomic_load(p, __ATOMIC_RELAXED, __HIP_MEMORY_SCOPE_AGENT); }
__device__ __forceinline__ unsigned xb_add(unsigned* p, unsigned v) { return __hip_atomic_fetch_add(p, v, __ATOMIC_RELAXED, __HIP_MEMORY_SCOPE_AGENT); }
__device__ __forceinline__ unsigned xb_xcc_id() { return (unsigned)__builtin_amdgcn_s_getreg((3 << 11) | 20) & 0xFu; }
#define XB_SPIN(cond, bar) do { unsigned _sp = 0; while (cond) { __builtin_amdgcn_s_sleep(1); \
    if ((++_sp & 255u) == 0u) { if (xb_ld(&(bar)[XB_TMO])) break; if (_sp > XB_SPIN_CAP) { atomicAdd(&(bar)[XB_TMO], 1u); break; } } } } while (0)
struct XcdBarrier { unsigned* bar; unsigned x; volatile LAS unsigned* st; };
__device__ __forceinline__ XcdBarrier xcd_barrier_post(unsigned* bar, volatile LAS unsigned* st) {
    XcdBarrier b; b.bar = bar; b.x = xb_xcc_id(); b.st = st;
    if (threadIdx.x == 0) (void)xb_add(&bar[XB_XCNT(b.x)], 1u);
    return b;
}
__device__ __forceinline__ void xcd_barrier_complete(unsigned* bar, unsigned x, unsigned& nloc, unsigned& nx) {
    const unsigned G = gridDim.x * gridDim.y * gridDim.z;
    unsigned sum, cnt, mine, sp = 0u;
    for (;;) {
        sum = 0u; cnt = 0u; mine = 0u;
#pragma unroll
        for (unsigned j = 0; j < 16; ++j) { const unsigned c = xb_ld(&bar[XB_XCNT(j)]); sum += c; cnt += (c > 0u) ? 1u : 0u; mine = (j == x) ? c : mine; }
        if (sum == G) break;
        __builtin_amdgcn_s_sleep(1);
        if ((++sp & 255u) == 0u) { if (xb_ld(&bar[XB_TMO])) break; if (sp > XB_SPIN_CAP) { atomicAdd(&bar[XB_TMO], 1u); break; } }
    }
    nloc = mine > 0u ? mine : 1u; nx = cnt > 0u ? cnt : 1u;
}
__device__ __forceinline__ void xcd_barrier(const XcdBarrier& b) {
    asm volatile("s_waitcnt vmcnt(0)" ::: "memory");
    __syncthreads();
    if (threadIdx.x == 0) {
        unsigned* bar = b.bar;
        __builtin_amdgcn_s_waitcnt(0);
        unsigned nloc = b.st[0], nx = b.st[1];
        if (nloc == 0u) { xcd_barrier_complete(bar, b.x, nloc, nx); b.st[0] = nloc; b.st[1] = nx; }
        const unsigned old = xb_add(&bar[XB_XSUB(b.x)], 1u);
        const unsigned gen = old / nloc;
        if (old + 1u == (gen + 1u) * nloc) {
            __builtin_amdgcn_fence(__ATOMIC_RELEASE, "agent");
            asm volatile("s_waitcnt vmcnt(0)" ::: "memory");
            const unsigned og = xb_add(&bar[XB_TOP], 1u);
            const unsigned tg = og / nx;
            if (og + 1u == (tg + 1u) * nx) xb_add(&bar[XB_TOPGEN], 1u);
            else XB_SPIN(xb_ld(&bar[XB_TOPGEN]) == tg, bar);
            __builtin_amdgcn_fence(__ATOMIC_ACQUIRE, "agent");
            xb_add(&bar[XB_XGEN(b.x)], 1u);
            asm volatile("s_waitcnt vmcnt(0)" ::: "memory");
        } else {
            XB_SPIN(xb_ld(&bar[XB_XGEN(b.x)]) == gen, bar);
            __builtin_amdgcn_fence(__ATOMIC_ACQUIRE, "agent");
            asm volatile("s_waitcnt vmcnt(0)" ::: "memory");
        }
    }
    __syncthreads();
}

struct Frame {
    LAS unsigned char* lds;
    volatile LAS unsigned* MISC;
    gu32* ctl;
    int tid, lane, wave, vcu, G;
    float* out;
    unsigned char* ws;
};
struct Args { const float* in[24]; float* out; unsigned char* ws; int ph_lo, ph_hi, li, pad; };
constexpr size_t WS_PAR = 512 * 1024;
constexpr int PAR_GQB = 0, PAR_GKB = 64, PAR_GKI = 128, PAR_GQM = 192, PAR_ALOG = 256, PAR_DTB = 260, PAR_GKM = 320, PAR_GO = 384, PAR_BNDB = 512, PAR_BNDC = 513, PAR_GQMX = 514, PAR_END = 520;

__device__ __forceinline__ int hperm(int tc) { return 64 * ((tc >> 5) & 3) + 32 * (tc >> 7) + (tc & 31); }
__device__ __forceinline__ int win_src_col(int np) {
    const int tile = np >> 8, tc = np & 255;
    if (tile < 8) return np;
    switch (tile) {
        case 8: return 2056 + hperm(tc);
        case 9: return 2312 + hperm(tc);
        case 10: return 2568 + tc;
        case 11: return 2824 + tc;
        case 12: return 3080 + tc;
        case 13: return 3376 + hperm(tc);
        case 14: return 3632 + tc;
        default:
            if (tc < 32) return 3336 + tc;
            if (tc < 36) return 2048 + tc - 32;
            if (tc < 40) return 2052 + tc - 36;
            if (tc < 48) return 3368 + tc - 40;
            return -1;
    }
}
__device__ __forceinline__ void p0_transpose_item(const float* W, int ldw, int K, bf16* WT, int n0, int k0, int srcc, LAS float* scr, int lane) {
#pragma unroll 8
    for (int i = 0; i < 32; ++i) { const int kk = 2 * i + (lane >> 5); scr[kk * 33 + (lane & 31)] = srcc >= 0 ? W[(size_t)(k0 + kk) * ldw + srcc] : 0.f; }
    LDS_WAIT(); asm volatile("" ::: "memory");
    const int c = lane & 7;
#pragma unroll
    for (int j = 0; j < 4; ++j) { const int n = (lane >> 3) + 8 * j; const LAS float* s = scr + (8 * c) * 33 + n;
        v4u o; o.x = pk2(s[0 * 33], s[1 * 33]); o.y = pk2(s[2 * 33], s[3 * 33]); o.z = pk2(s[4 * 33], s[5 * 33]); o.w = pk2(s[6 * 33], s[7 * 33]);
        *(GAS v4u*)(WT + (size_t)(n0 + n) * K + k0 + 8 * c) = o; }
    LDS_WAIT(); asm volatile("" ::: "memory");
}
__device__ __forceinline__ void rms_row_to_bf16(const float* xrow, const float* g, bf16* orow, int lane) {
    const GAS f32x4* xr = (const GAS f32x4*)xrow + lane; const GAS f32x4* gr = (const GAS f32x4*)g + lane;
    f32x4 v[4]; float s = 0.f;
#pragma unroll
    for (int j = 0; j < 4; ++j) { v[j] = xr[64 * j]; s += (v[j].x * v[j].x + v[j].y * v[j].y) + (v[j].z * v[j].z + v[j].w * v[j].w); }
    const float rs = 1.0f / sqrtf(wave_sum(s) * (1.f / 1024.f) + EPS);
    GAS v2u* o8 = (GAS v2u*)orow + lane;
#pragma unroll
    for (int j = 0; j < 4; ++j) { const f32x4 gg = gr[64 * j]; v2u w; w.x = pk2(v[j].x * rs * gg.x, v[j].y * rs * gg.y); w.y = pk2(v[j].z * rs * gg.z, v[j].w * rs * gg.w); o8[64 * j] = w; }
}
__device__ __forceinline__ void p0_prologue(Frame& F, const Args& A) {
    LAS float* scr = (LAS float*)(F.lds + LDS_MAIN + F.wave * 16384);
    const int gw = F.vcu * NWAVES + F.wave, NGW = F.G * NWAVES;
    if (blockIdx.x == 0) {
        float* par = (float*)(F.ws + WS_PAR); const int t = F.tid;
        if (t < 64) { par[PAR_GQB + t] = A.in[16][t]; par[PAR_GKB + t] = A.in[17][t]; par[PAR_GQM + t] = A.in[21][t]; par[PAR_GKM + t] = A.in[22][t]; }
        if (t < 32) par[PAR_GKI + t] = A.in[18][t];
        if (t < 4) { par[PAR_ALOG + t] = A.in[13][t]; par[PAR_DTB + t] = A.in[14][t]; }
        if (t < 128) par[PAR_GO + t] = A.in[15][t];
        if (t < 64) {
            float a = fabsf(A.in[16][t]), b = fabsf(A.in[17][t]), c2 = fabsf(A.in[21][t]), d = fabsf(A.in[22][t]);
#pragma unroll
            for (int o = 1; o < 64; o <<= 1) { a = fmaxf(a, __shfl_xor(a, o)); b = fmaxf(b, __shfl_xor(b, o)); c2 = fmaxf(c2, __shfl_xor(c2, o)); d = fmaxf(d, __shfl_xor(d, o)); }
            if (t == 0) { par[PAR_BNDB] = 8.0f * a * b * 1.4426950408889634f; par[PAR_BNDC] = 8.0f * c2 * d * 1.4426950408889634f; par[PAR_GQMX] = c2; }
        }
    }
    constexpr int I_IN = 16 * 128, I_OUT = 16 * 32, I_MEM = 16 * 16;
    bf16* WinT = (bf16*)(F.ws + WS_WIN); bf16* WoutT = (bf16*)(F.ws + WS_WOUT); bf16* WmemT = WinT + (size_t)NIN * DM;
    for (int it = gw; it < I_IN + I_OUT + I_MEM; it += NGW) {
        int r = it;
        if (r < I_IN) { const int kb = r / 128, nb = r % 128; p0_transpose_item(A.in[11], WIN, 1024, WinT, 32 * nb, 64 * kb, win_src_col(32 * nb + (F.lane & 31)), scr, F.lane); continue; }
        r -= I_IN;
        if (r < I_OUT) { const int kb = r / 32, nb = r % 32; p0_transpose_item(A.in[23], 1024, 1024, WoutT, 32 * nb, 64 * kb, 32 * nb + (F.lane & 31), scr, F.lane); continue; }
        r -= I_OUT;
        { const int kb = r / 16, nb = r % 16; const int np = 32 * nb + (F.lane & 31); p0_transpose_item(A.in[20], 512, 1024, WmemT, 32 * nb, 64 * kb, np < 256 ? hperm(np) : np, scr, F.lane); }
    }
    bf16* XN = (bf16*)(F.ws + WS_XN);
    f32x4 gA[4], gM[4];
#pragma unroll
    for (int j = 0; j < 4; ++j) { gA[j] = *((const GAS f32x4*)A.in[10] + F.lane + 64 * j); gM[j] = *((const GAS f32x4*)A.in[19] + F.lane + 64 * j); }
#pragma unroll 1
    for (int m0 = gw; m0 < MALL; m0 += 5 * NGW) {
        f32x4 v[5][4]; bool live[5], zero[5], memg[5];
#pragma unroll
        for (int i = 0; i < 5; ++i) {
            const int m = m0 + i * NGW; live[i] = m < MALL; const int mm = live[i] ? m : 0;
            zero[i] = mm >= MTOK && mm < MPAD;
            const float* src = mm < MP ? A.in[0] + (size_t)mm * DM : (mm < MTOK ? A.in[1] + (size_t)(mm - MP) * DM : (mm < MPAD ? A.in[0] : A.in[9] + (size_t)(mm - MPAD) * DM));
            memg[i] = mm >= MPAD;
#pragma unroll
            for (int j = 0; j < 4; ++j) v[i][j] = *((const GAS f32x4*)src + F.lane + 64 * j);
        }
#pragma unroll
        for (int i = 0; i < 5; ++i) {
            float s = 0.f;
#pragma unroll
            for (int j = 0; j < 4; ++j) s += (v[i][j].x * v[i][j].x + v[i][j].y * v[i][j].y) + (v[i][j].z * v[i][j].z + v[i][j].w * v[i][j].w);
            const float rs = zero[i] ? 0.f : 1.0f / sqrtf(wave_sum(s) * (1.f / 1024.f) + EPS);
            if (live[i]) {
                GAS v2u* o8 = (GAS v2u*)(XN + (size_t)(m0 + i * NGW) * DM) + F.lane;
#pragma unroll
                for (int j = 0; j < 4; ++j) { const f32x4 gg = memg[i] ? gM[j] : gA[j];
                    v2u w; w.x = pk2(v[i][j].x * rs * gg.x, v[i][j].y * rs * gg.y); w.y = pk2(v[i][j].z * rs * gg.z, v[i][j].w * rs * gg.w); o8[64 * j] = w; }
            }
        }
    }
}

__device__ __forceinline__ v4u pack8(const f32x4 a, const f32x4 b) { v4u w; w.x = pk2(a[0], a[1]); w.y = pk2(a[2], a[3]); w.z = pk2(b[0], b[1]); w.w = pk2(b[2], b[3]); return w; }
struct InOrder {
    pg8::StaticOrder so;
    __device__ void init(int G_, int c_) { so.init(MPAD, 15 * 256, G_, c_); }
    __device__ bool next(int i, pg8::Unit& u) const { return so.next(i, u); }
    __device__ __forceinline__ void a_ready(const pg8::Unit&) const {}
    __device__ __forceinline__ void done(const pg8::Unit&) const {}
};
struct MemOrder {
    int bx;
    __device__ bool next(int i, pg8::Unit& u) const { if (i != 0) return false; u.pm = 65 + (bx >> 1); u.pn = 16 + (bx & 1); return true; }
    __device__ __forceinline__ void a_ready(const pg8::Unit&) const {}
    __device__ __forceinline__ void done(const pg8::Unit&) const {}
};
struct EpiIn {
    static constexpr bool PERM = true, AFTER_DRAIN = false;
    unsigned char* ws; float* out;
    __device__ __forceinline__ void operator()(const pg8::f32x4 (&acc)[2][2][4][2], const pg8::Unit& u, int wr, int wc, int fr, int fq) const {
        const int pn = u.pn, tcb = wc * 32 + 8 * fq;
        const bool hp = (pn == 8 || pn == 9 || pn == 13 || pn == 16);
        const bool gate = (pn == 6 || pn == 7 || pn == 11 || pn == 14);
        size_t b16 = 0; int ld16 = 256, c16 = hp ? wc * 64 + 8 * fq : tcb, bjs = hp ? 32 : 128; int gpar = 0;
        switch (pn) {
            case 0: case 1: case 2: case 3: case 4: case 5: b16 = WS_QKVA; ld16 = 1536; c16 += pn * 256; break;
            case 6: case 7: b16 = WS_ZA; ld16 = 512; c16 += (pn - 6) * 256; break;
            case 8: b16 = WS_QB; gpar = PAR_GQB; break;
            case 9: b16 = WS_KB; gpar = PAR_GKB; break;
            case 10: b16 = WS_VB; break;
            case 11: b16 = WS_ZB; break;
            case 12: b16 = WS_QI; break;
            case 13: b16 = WS_QM; gpar = PAR_GQM; break;
            case 14: b16 = WS_ZM; break;
            case 16: b16 = WS_MEMK; gpar = PAR_GKM; break;
            case 17: b16 = WS_MEMV; break;
            default: break;
        }
        const float* par = (const float*)(ws + WS_PAR);
#pragma unroll
        for (int ai = 0; ai < 2; ++ai)
#pragma unroll
        for (int m = 0; m < 4; ++m) {
            int row = u.pm * 256 + ai * 128 + wr * 64 + m * 16 + fr;
            const bool memrow = pn >= 16;
            if (memrow) row -= MPAD;
            const bool valid = memrow || row < MTOK;
            const bool prompt = row < MP;
            if (pn != 15) {
                f32x4 v[2][2];
#pragma unroll
                for (int bj = 0; bj < 2; ++bj) { v[bj][0] = acc[ai][bj][m][0]; v[bj][1] = acc[ai][bj][m][1]; }
                if (gate) {
#pragma unroll
                    for (int bj = 0; bj < 2; ++bj)
#pragma unroll
                        for (int n = 0; n < 2; ++n)
#pragma unroll
                            for (int j = 0; j < 4; ++j) v[bj][n][j] = silu_f(v[bj][n][j]);
                }
                if (hp) {
                    float ss = 0.f;
#pragma unroll
                    for (int bj = 0; bj < 2; ++bj)
#pragma unroll
                        for (int n = 0; n < 2; ++n) { const f32x4 x = v[bj][n]; ss += (x[0] * x[0] + x[1] * x[1]) + (x[2] * x[2] + x[3] * x[3]); }
                    ss += __shfl_xor(ss, 16); ss += __shfl_xor(ss, 32);
                    const float rs = 1.0f / sqrtf(ss * (1.f / 64.f) + EPS);
#pragma unroll
                    for (int bj = 0; bj < 2; ++bj)
#pragma unroll
                        for (int n = 0; n < 2; ++n) v[bj][n] = v[bj][n] * rs * *(const GAS f32x4*)(par + gpar + 32 * bj + 8 * fq + 4 * n);
                }
                if (valid) {
                    bf16* dst = (bf16*)(ws + b16) + (size_t)row * ld16 + c16;
                    float* o = nullptr;
                    if (pn == 9) o = out + (prompt ? OFF_PK + (size_t)row * 256 : OFF_SK + (size_t)(row - MP) * 256) + c16;
                    else if (pn == 10) o = out + (prompt ? OFF_PV + (size_t)row * 256 : OFF_SV + (size_t)(row - MP) * 256) + c16;
                    else if (pn == 16) o = out + OFF_PMK + (size_t)row * 256 + c16;
                    else if (pn == 17) o = out + OFF_PMV + (size_t)row * 256 + c16;
                    else if (pn < 6) {
                        if (prompt) { const int t = row & 2047; if (t >= 2045) o = out + OFF_PCONV + (size_t)((row >> 11) * 3 + (t - 2045)) * 1536 + c16; }
                        else { const int rr = row - MP, t = rr & 15; if (t >= 13) o = out + OFF_SCONV + (size_t)((rr >> 4) * 3 + (t - 13)) * 1536 + c16; }
                    }
#pragma unroll
                    for (int bj = 0; bj < 2; ++bj) {
                        *(GAS v4u*)(dst + bj * bjs) = pack8(v[bj][0], v[bj][1]);
                        if (o) { *(GAS f32x4*)(o + bj * bjs) = v[bj][0]; *(GAS f32x4*)(o + bj * bjs + 4) = v[bj][1]; }
                    }
                }
            } else {
                const f32x4 x0 = acc[ai][0][m][0], x1 = acc[ai][0][m][1];
                if (wc == 0) {
                    float ss = (x0[0] * x0[0] + x0[1] * x0[1]) + (x0[2] * x0[2] + x0[3] * x0[3]) + (x1[0] * x1[0] + x1[1] * x1[1]) + (x1[2] * x1[2] + x1[3] * x1[3]);
                    ss += __shfl_xor(ss, 16); ss += __shfl_xor(ss, 32);
                    const float rs = 1.0f / sqrtf(ss * (1.f / 32.f) + EPS);
                    if (valid) {
                        const f32x4 a = x0 * rs * *(const GAS f32x4*)(par + PAR_GKI + 8 * fq), b = x1 * rs * *(const GAS f32x4*)(par + PAR_GKI + 8 * fq + 4);
                        float* o = out + (prompt ? OFF_PKI + (size_t)row * 32 : OFF_SKI + (size_t)(row - MP) * 32) + 8 * fq;
                        *(GAS f32x4*)o = a; *(GAS f32x4*)(o + 4) = b;
                        *(GAS v4u*)((bf16*)(ws + WS_KI) + (size_t)row * 32 + 8 * fq) = pack8(a, b);
                    }
                } else if (wc == 1 && valid && fq < 2) {
                    float* sm = (float*)(ws + WS_SMALL) + (size_t)row * 16 + 8 * fq;
                    const float sc = fq == 0 ? 1.0f : IDX_SCALE;
                    *(GAS f32x4*)sm = x0 * sc; *(GAS f32x4*)(sm + 4) = x1 * sc;
                }
            }
        }
    }
};
struct EpiOut {
    static constexpr bool PERM = true, AFTER_DRAIN = false;
    const float* xp; const float* xs; float* out;
    __device__ __forceinline__ void operator()(const pg8::f32x4 (&acc)[2][2][4][2], const pg8::Unit& u, int wr, int wc, int fr, int fq) const {
        const int col0 = u.pn * 256 + wc * 32 + 8 * fq;
#pragma unroll
        for (int ai = 0; ai < 2; ++ai)
#pragma unroll
        for (int m = 0; m < 4; ++m) {
            const int row = u.pm * 256 + ai * 128 + wr * 64 + m * 16 + fr;
            if (row < MTOK) {
                const float* xr = (row < MP ? xp + (size_t)row * DM : xs + (size_t)(row - MP) * DM) + col0;
                float* o = out + (size_t)row * DM + col0;
#pragma unroll
                for (int bj = 0; bj < 2; ++bj) {
                    const f32x4 x0 = *(const GAS f32x4*)(xr + bj * 128), x1 = *(const GAS f32x4*)(xr + bj * 128 + 4);
                    *(GAS f32x4*)(o + bj * 128) = x0 + acc[ai][bj][m][0]; *(GAS f32x4*)(o + bj * 128 + 4) = x1 + acc[ai][bj][m][1];
                }
            }
        }
    }
};

constexpr int SW_RS = 2064;
__device__ __forceinline__ void small_stage_w(unsigned char* ws, LAS unsigned char* L, int tid) {
    const bf16* WT = (const bf16*)(ws + WS_WIN) + (size_t)3840 * DM;
#pragma unroll
    for (int i = 0; i < 12; ++i) { const int q = tid + 512 * i, row = q >> 7, c16 = q & 127; *(LAS v4u*)(L + row * SW_RS + 16 * c16) = *(const GAS v4u*)(WT + (size_t)row * DM + 8 * c16); }
}
__device__ __forceinline__ void small_item(unsigned char* ws, float* out, const LAS unsigned char* L, int r0, int tid_) {
    int tid = tid_; asm volatile("" : "+v"(tid));
    const int lane = tid & 63, wave = __builtin_amdgcn_readfirstlane(tid >> 6), g = lane >> 4, c = lane & 15;
    const bf16* XN = (const bf16*)(ws + WS_XN) + (size_t)(r0 + 16 * wave + c) * DM + 8 * g;
    const LAS unsigned char* WL = L + c * SW_RS + 16 * g;
    f32x4 acc[3] = {{0.f, 0.f, 0.f, 0.f}, {0.f, 0.f, 0.f, 0.f}, {0.f, 0.f, 0.f, 0.f}};
    bf16x8 a[32];
#pragma unroll
    for (int i = 0; i < 32; ++i) a[i] = *(const GAS bf16x8*)(XN + 32 * i);
#pragma unroll
    for (int i = 0; i < 32; ++i)
#pragma unroll
        for (int t = 0; t < 3; ++t) acc[t] = __builtin_amdgcn_mfma_f32_16x16x32_bf16(a[i], *(const LAS bf16x8*)(WL + 16 * t * SW_RS + 64 * i), acc[t], 0, 0, 0);
    const float* par = (const float*)(ws + WS_PAR);
    const float gk0 = par[PAR_GKI + c], gk1 = par[PAR_GKI + 16 + c];
#pragma unroll
    for (int r = 0; r < 4; ++r) {
        const int row = r0 + 16 * wave + 4 * g + r;
        float ss = acc[0][r] * acc[0][r] + acc[1][r] * acc[1][r];
        ss += __shfl_xor(ss, 1); ss += __shfl_xor(ss, 2); ss += __shfl_xor(ss, 4); ss += __shfl_xor(ss, 8);
        const float rs = 1.0f / sqrtf(ss * (1.f / 32.f) + EPS);
        if (row < MTOK) {
            const float k0 = acc[0][r] * rs * gk0, k1 = acc[1][r] * rs * gk1;
            float* o = out + (row < MP ? OFF_PKI + (size_t)row * 32 : OFF_SKI + (size_t)(row - MP) * 32);
            o[c] = k0; o[16 + c] = k1;
            bf16* kd = (bf16*)(ws + WS_KI) + (size_t)row * 32;
            kd[c] = (bf16)f2bf(k0); kd[16 + c] = (bf16)f2bf(k1);
            ((float*)(ws + WS_SMALL))[(size_t)row * 16 + c] = c < 8 ? acc[2][r] : acc[2][r] * IDX_SCALE;
        }
    }
}
__device__ __forceinline__ void sample_out_item(unsigned char* ws, const float* xs, float* out, int bx, int tid_) {
    int tid = tid_; asm volatile("" : "+v"(tid));
    const int lane = tid & 63, wave = __builtin_amdgcn_readfirstlane(tid >> 6), g = lane >> 4, c = lane & 15;
    const bf16* MX = (const bf16*)(ws + WS_MIX) + (size_t)(MP + 16 * wave + c) * DM + 8 * g;
    const bf16* WT = (const bf16*)(ws + WS_WOUT) + (size_t)(16 * bx + c) * DM + 8 * g;
    f32x4 acc = {0.f, 0.f, 0.f, 0.f};
#pragma unroll 1
    for (int k0 = 0; k0 < 32; k0 += 16) {
        bf16x8 a[16], w[16];
#pragma unroll
        for (int i = 0; i < 16; ++i) { a[i] = *(const GAS bf16x8*)(MX + 32 * (k0 + i)); w[i] = *(const GAS bf16x8*)(WT + 32 * (k0 + i)); }
        __builtin_amdgcn_sched_barrier(0);
#pragma unroll
        for (int i = 0; i < 16; ++i) acc = __builtin_amdgcn_mfma_f32_16x16x32_bf16(a[i], w[i], acc, 0, 0, 0);
    }
#pragma unroll
    for (int r = 0; r < 4; ++r) { const int row = 16 * wave + 4 * g + r; out[OFF_YS + (size_t)row * DM + 16 * bx + c] = xs[(size_t)row * DM + 16 * bx + c] + acc[r]; }
}

#define MFMA16(a, b, c) __builtin_amdgcn_mfma_f32_16x16x32_bf16((a), (b), (c), 0, 0, 0)
typedef short v4i16_t __attribute__((ext_vector_type(4)));
__device__ __forceinline__ bf16x8 lds_frag16(const LAS unsigned char* p) { return *(const LAS bf16x8*)p; }
__device__ __forceinline__ bf16x8 cat44(s16x4 lo, s16x4 hi) { bf16x8 r; r[0] = lo[0]; r[1] = lo[1]; r[2] = lo[2]; r[3] = lo[3]; r[4] = hi[0]; r[5] = hi[1]; r[6] = hi[2]; r[7] = hi[3]; return r; }
__device__ __forceinline__ bf16x8 lds_frag_perm(const LAS unsigned char* rowp_kbase, int g) {
    const s16x4 lo = *(const LAS s16x4*)(rowp_kbase + 8 * g), hi = *(const LAS s16x4*)(rowp_kbase + 32 + 8 * g);
    return cat44(lo, hi);
}
__device__ __forceinline__ bf16x8 acc_to_bfrag(const f32x4 t0, const f32x4 t1) {
    v4u w; w.x = pk2(t0[0], t0[1]); w.y = pk2(t0[2], t0[3]); w.z = pk2(t1[0], t1[1]); w.w = pk2(t1[2], t1[3]);
    return __builtin_bit_cast(bf16x8, w);
}

constexpr int P2_QT = 0, P2_KT = 17408, P2_KBT = 34816, P2_VB = 52224, P2_LM = 86016, P2_SSQ = 102400, P2_SCAL = 110592, P2_LB = 112640, P2_DINV = 121856;
constexpr int P2_RS = 272;
struct P2Regs { float w[4][8]; v4u xr[11]; float braw[8]; float b7, a7; };
__device__ __forceinline__ void p2_decode(int it, int& b, int& h, int& n, int& row0, int& nreal, bool& samp) {
    samp = it >= 1024;
    if (!samp) { const int bh = it >> 5; b = bh >> 2; h = bh & 3; n = it & 31; row0 = b * T + 64 * n; nreal = 64; }
    else { b = (it - 1024) >> 2; h = (it - 1024) & 3; n = 0; row0 = MP + 16 * b; nreal = 16; }
}
template <int NR, int SEC>
__device__ __forceinline__ void p2_pass_load(P2Regs& R, const Args& A, const bf16* QKVA, const float* SM, int rbase, int cc, int it, bool loadw) {
    int b, h, n, row0, nreal; bool samp; p2_decode(it, b, h, n, row0, nreal, samp);
    const int col = SEC * 512 + h * 128 + 8 * cc;
    if (loadw) {
#pragma unroll
        for (int j = 0; j < 4; ++j) { const f32x4 a = *(const GAS f32x4*)(A.in[12] + j * 1536 + col), c = *(const GAS f32x4*)(A.in[12] + j * 1536 + col + 4);
            R.w[j][0] = a[0]; R.w[j][1] = a[1]; R.w[j][2] = a[2]; R.w[j][3] = a[3]; R.w[j][4] = c[0]; R.w[j][5] = c[1]; R.w[j][6] = c[2]; R.w[j][7] = c[3]; }
    }
    if (samp) {
#pragma unroll
        for (int j = 0; j < NR + 3; ++j) {
            const int rr = rbase + j - 3;
            const int rh = rr < 0 ? 3 + rr : 0;
            const float* sp = A.in[2] + (size_t)(b * 3 + rh) * 1536 + col;
            const f32x4 a = *(const GAS f32x4*)sp, c = *(const GAS f32x4*)(sp + 4);
            const int rc = rr < 0 ? 0 : (rr < 16 ? rr : 15);
            const v4u q = *(const GAS v4u*)(QKVA + (size_t)(row0 + rc) * 1536 + col);
            const v4u hst = pack8(a, c);
            R.xr[j] = rr < 0 ? hst : (rr < 16 ? q : (v4u){0u, 0u, 0u, 0u});
        }
    } else {
#pragma unroll
        for (int j = 0; j < NR + 3; ++j) {
            const int rr = rbase + j - 3;
            const bool zero = rr < 0 && n == 0;
            const v4u q = *(const GAS v4u*)(QKVA + (size_t)(row0 + (zero ? 0 : rr)) * 1536 + col);
            R.xr[j] = zero ? (v4u){0u, 0u, 0u, 0u} : q;
        }
    }
    if (SEC != 0) { const int rr = rbase + (cc & (NR - 1)); R.braw[0] = SM[(size_t)(row0 + (rr < nreal ? rr : 0)) * 16 + h]; }
}
template <int NR, int SEC>
__device__ __forceinline__ void p2_pass_compute(const P2Regs& R, LAS unsigned char* L, int rbase, int cc, int nreal, int lane) {
#pragma unroll
    for (int r = 0; r < NR; ++r) {
        const int row = rbase + r;
        const bool real = row < nreal;
        const float rmask = real ? 1.f : 0.f;
        float val[8]; float p = 0.f;
#pragma unroll
        for (int e = 0; e < 8; ++e) {
            const int wd = e >> 1; const bool hi = e & 1;
            const float x0 = hi ? bfhi(R.xr[r][wd]) : bflo(R.xr[r][wd]), x1 = hi ? bfhi(R.xr[r + 1][wd]) : bflo(R.xr[r + 1][wd]);
            const float x2 = hi ? bfhi(R.xr[r + 2][wd]) : bflo(R.xr[r + 2][wd]), x3 = hi ? bfhi(R.xr[r + 3][wd]) : bflo(R.xr[r + 3][wd]);
            float y = R.w[0][e] * x0 + R.w[1][e] * x1 + R.w[2][e] * x2 + R.w[3][e] * x3;
            y = silu_f(y) * rmask;
            val[e] = y; if (SEC != 2) p += y * y;
        }
        float rs = 0.f;
        if (SEC != 2) {
            p += __builtin_bit_cast(float, __builtin_amdgcn_update_dpp(0, __builtin_bit_cast(int, p), 0x128, 0xf, 0xf, false));
            p += __builtin_bit_cast(float, __builtin_amdgcn_update_dpp(0, __builtin_bit_cast(int, p), 0x124, 0xf, 0xf, false));
            p += __builtin_bit_cast(float, __builtin_amdgcn_update_dpp(0, __builtin_bit_cast(int, p), 0x122, 0xf, 0xf, false));
            p += __builtin_bit_cast(float, __builtin_amdgcn_update_dpp(0, __builtin_bit_cast(int, p), 0x121, 0xf, 0xf, false));
            rs = __builtin_amdgcn_rsqf(p + EPS);
        }
        float be = 0.f;
        if (SEC != 0) { const float br = __shfl(R.braw[0], (lane & 48) + r); be = frcp(1.0f + fexp2(-1.4426950408889634f * br)) * rmask; }
        if (SEC == 0) {
            const float sc = rs * 0.08838834764831845f;
            v4u o; o.x = pk2(val[0] * sc, val[1] * sc); o.y = pk2(val[2] * sc, val[3] * sc); o.z = pk2(val[4] * sc, val[5] * sc); o.w = pk2(val[6] * sc, val[7] * sc);
            *(LAS v4u*)(L + P2_QT + row * P2_RS + 16 * cc) = o;
        } else if (SEC == 1) {
            const float bs = be * rs;
            v4u o; o.x = pk2(val[0] * rs, val[1] * rs); o.y = pk2(val[2] * rs, val[3] * rs); o.z = pk2(val[4] * rs, val[5] * rs); o.w = pk2(val[6] * rs, val[7] * rs);
            *(LAS v4u*)(L + P2_KT + row * P2_RS + 16 * cc) = o;
            v4u q; q.x = pk2(val[0] * bs, val[1] * bs); q.y = pk2(val[2] * bs, val[3] * bs); q.z = pk2(val[4] * bs, val[5] * bs); q.w = pk2(val[6] * bs, val[7] * bs);
            *(LAS v4u*)(L + P2_KBT + row * P2_RS + 16 * cc) = q;
        } else {
            LAS float* vp = (LAS float*)(L + P2_VB) + row * 132 + 8 * cc;
            *(LAS f32x4*)vp = (f32x4){val[0] * be, val[1] * be, val[2] * be, val[3] * be};
            *(LAS f32x4*)(vp + 4) = (f32x4){val[4] * be, val[5] * be, val[6] * be, val[7] * be};
        }
    }
}
template <bool ISU>
__device__ __forceinline__ void p2_solve(Frame& F, LAS unsigned char* L, const LAS float* scal, int it, int wave, int g, int c) {
        const f32x4 z4 = {0.f, 0.f, 0.f, 0.f};
        f32x4 X[2][4];
#pragma unroll
        for (int I = 0; I < 4; ++I) {
            f32x4 R[2];
#pragma unroll
            for (int tq = 0; tq < 2; ++tq) {
                const int col = 16 * ((2 * wave + tq) & 7) + c;
#pragma unroll
                for (int r = 0; r < 4; ++r) { const int i = 16 * I + 4 * g + r;
                    R[tq][r] = ISU ? ((const LAS float*)(L + P2_VB))[i * 132 + col] : bf2f(*(const LAS unsigned short*)(L + P2_KBT + i * P2_RS + 2 * col)) * scal[128 + i]; }
            }
            const LAS unsigned char* Lrow = L + P2_LB + (16 * I + c) * 144;
            bf16x8 la = {}, lb = {};
            if (I >= 1) la = lds_frag_perm(Lrow, g);
            if (I == 3) lb = lds_frag_perm(Lrow + 64, g);
            const s16x4 dlo = *(const LAS s16x4*)(L + P2_DINV + (16 * I + c) * 40 + 8 * g);
            const bf16x8 da = cat44(dlo, (s16x4){0, 0, 0, 0});
#pragma unroll
            for (int tq = 0; tq < 2; ++tq) {
                if (I == 1) R[tq] = MFMA16(la, acc_to_bfrag(X[tq][0], z4), R[tq]);
                if (I >= 2) R[tq] = MFMA16(la, acc_to_bfrag(X[tq][0], X[tq][1]), R[tq]);
                if (I == 3) R[tq] = MFMA16(lb, acc_to_bfrag(X[tq][2], z4), R[tq]);
            }
            f32x4 Rh[2], Rl[2];
#pragma unroll
            for (int tq = 0; tq < 2; ++tq)
#pragma unroll
                for (int r = 0; r < 4; ++r) { Rh[tq][r] = bf2f((unsigned short)f2bf(R[tq][r])); Rl[tq][r] = R[tq][r] - Rh[tq][r]; }
#pragma unroll
            for (int tq = 0; tq < 2; ++tq) X[tq][I] = MFMA16(da, acc_to_bfrag(Rh[tq], z4), z4);
#pragma unroll
            for (int tq = 0; tq < 2; ++tq) X[tq][I] = MFMA16(da, acc_to_bfrag(Rl[tq], z4), X[tq][I]);
#pragma unroll
            for (int tq = 0; tq < 2; ++tq) {
                const int col = 16 * ((2 * wave + tq) & 7) + c;
                bf16* dst = (ISU ? (bf16*)(F.ws + WS_GU0) : (bf16*)(F.ws + WS_GWK)) + (size_t)it * 8192 + col;
#pragma unroll
                for (int r = 0; r < 4; ++r)
                    dst[(16 * I + 4 * g + r) * 128] = (bf16)f2bf(ISU ? X[tq][I][r] : -X[tq][I][r]);
            }
        }
}
__device__ __forceinline__ void p2_load_all(P2Regs& R, Frame& F, const Args& A, int it, int tid, int wave, int lane, bool loadw) {
    const bf16* QKVA = (const bf16*)(F.ws + WS_QKVA); const float* SM = (const float*)(F.ws + WS_SMALL);
    const int k4 = (tid >> 4) & 3, cc = tid & 15;
    if (wave < 2) p2_pass_load<8, 0>(R, A, QKVA, SM, 8 * (4 * wave + k4), cc, it, loadw);
    else if (wave < 4) p2_pass_load<8, 1>(R, A, QKVA, SM, 8 * (4 * (wave - 2) + k4), cc, it, loadw);
    else p2_pass_load<4, 2>(R, A, QKVA, SM, 4 * (4 * (wave - 4) + k4), cc, it, loadw);
    R.b7 = 0.f; R.a7 = 0.f;
    if (wave == 7) { int b, h, n, row0, nreal; bool samp; p2_decode(it, b, h, n, row0, nreal, samp);
        if (lane < nreal) { R.b7 = SM[(size_t)(row0 + lane) * 16 + h]; R.a7 = SM[(size_t)(row0 + lane) * 16 + 4 + h]; } }
}
__device__ __forceinline__ void p2_body(Frame& F, const Args& A, int it, int itnext, P2Regs& R, int tid) {
    const int lane = tid & 63, wave = __builtin_amdgcn_readfirstlane(tid >> 6);
    LAS unsigned char* L = F.lds;
    LAS float* ssq = (LAS float*)(L + P2_SSQ);
    LAS float* scal = (LAS float*)(L + P2_SCAL);
    const bool samp = it >= 1024;
    int b, h, n, row0, nreal;
    if (!samp) { const int bh = it >> 5; b = bh >> 2; h = bh & 3; n = it & 31; row0 = b * T + 64 * n; nreal = 64; }
    else { b = (it - 1024) >> 2; h = (it - 1024) & 3; n = 0; row0 = MP + 16 * b; nreal = 16; }
    const bf16* QKVA = (const bf16*)(F.ws + WS_QKVA);
    const float* SM = (const float*)(F.ws + WS_SMALL);
    const float* par = (const float*)(F.ws + WS_PAR);

    const float braw7 = R.b7, araw7 = R.a7;
    {
        const int k4 = (tid >> 4) & 3, cc = tid & 15;
        if (wave < 2) p2_pass_compute<8, 0>(R, L, 8 * (4 * wave + k4), cc, nreal, lane);
        else if (wave < 4) p2_pass_compute<8, 1>(R, L, 8 * (4 * (wave - 2) + k4), cc, nreal, lane);
        else p2_pass_compute<4, 2>(R, L, 4 * (4 * (wave - 4) + k4), cc, nreal, lane);
    }
    if (wave == 7) {
        float be = 0.f, g = 0.f;
        if (lane < nreal) {
            be = 1.0f / (1.0f + expf(-braw7));
            const float z = araw7 + par[PAR_DTB + h]; const float sp = z > 20.f ? z : log1pf(expf(z));
            g = -expf(par[PAR_ALOG + h]) * sp;
        }
        float gc = g;
#pragma unroll
        for (int o = 1; o < 64; o <<= 1) { const float t = __shfl_up(gc, o); if (lane >= o) gc += t; }
        const float gl = __shfl(gc, 63);
        scal[lane] = be; scal[64 + lane] = gc; scal[128 + lane] = expf(gc); scal[192 + lane] = expf(gl - gc);
        if (lane == 0) ((float*)(F.ws + WS_GLAST))[it] = expf(gl);
    }
    __syncthreads();

    if (itnext < NGITEM) {
        int b2, h2, n2, r2, nr2; bool s2; p2_decode(itnext, b2, h2, n2, r2, nr2, s2);
        p2_load_all(R, F, A, itnext, tid, wave, lane, h2 != h);
    }
    {
        const int g = lane >> 4, c = lane & 15;
        bf16* GQK = (bf16*)(F.ws + WS_GQK) + (size_t)it * 4096;
        LAS float* Lm = (LAS float*)(L + P2_LM);
#pragma unroll
        for (int q = 0; q < 3; ++q) {
            const int job = wave + 8 * q;
            if (job >= 20) break;
            const int tt = job >> 1; const bool isqk = job & 1;
            const int ti = tt < 1 ? 0 : (tt < 3 ? 1 : (tt < 6 ? 2 : 3)), tj = tt - (ti * (ti + 1)) / 2;
            f32x4 acc = {0.f, 0.f, 0.f, 0.f};
            {
                const LAS unsigned char* Ap = L + (isqk ? P2_QT : P2_KBT) + (16 * ti + c) * P2_RS + 16 * g;
                const LAS unsigned char* Bp = L + P2_KT + (16 * tj + c) * P2_RS + 16 * g;
#pragma unroll
                for (int ks = 0; ks < 4; ++ks) acc = MFMA16(lds_frag16(Ap + 64 * ks), lds_frag16(Bp + 64 * ks), acc);
            }
            const int j = 16 * tj + c; const float gcj = scal[64 + j];
#pragma unroll
            for (int r = 0; r < 4; ++r) {
                const int i = 16 * ti + 4 * g + r;
                const float dec = fexp2(1.4426950408889634f * fminf(scal[64 + i] - gcj, 0.f));
                if (!isqk) { const float lv = (j < i) ? acc[r] * dec : 0.f; Lm[i * 64 + j] = lv; *(LAS unsigned short*)(L + P2_LB + i * 144 + 2 * j) = (unsigned short)f2bf(-lv); }
                else GQK[i * 64 + j] = (bf16)f2bf((j <= i) ? acc[r] * dec : 0.f);
            }
        }
        if (wave >= 2) {
            const int z = wave - 2, ti = z < 3 ? 0 : (z < 5 ? 1 : 2), tj = z < 3 ? z + 1 : (z < 5 ? z - 1 : 3);
#pragma unroll
            for (int r = 0; r < 4; ++r) GQK[(16 * ti + 4 * g + r) * 64 + 16 * tj + c] = (bf16)0;
        }
    }
    __syncthreads();

    if (tid < 64) {
        const int I = tid >> 4, jj = tid & 15;
        const LAS float* Ld = (const LAS float*)(L + P2_LM) + (16 * I) * 64 + 16 * I;
        float t[16];
#pragma unroll
        for (int ii = 0; ii < 16; ++ii) {
            float r = ii == jj ? 1.f : 0.f;
#pragma unroll
            for (int k4 = 0; k4 < (ii + 3) / 4; ++k4) {
                const f32x4 l4 = *(const LAS f32x4*)(Ld + ii * 64 + 4 * k4);
                r -= l4[0] * t[4 * k4];
                if (4 * k4 + 1 < ii) r -= l4[1] * t[4 * k4 + 1];
                if (4 * k4 + 2 < ii) r -= l4[2] * t[4 * k4 + 2];
                if (4 * k4 + 3 < ii) r -= l4[3] * t[4 * k4 + 3];
            }
            t[ii] = r;
            *(LAS unsigned short*)(L + P2_DINV + (16 * I + ii) * 40 + 2 * jj) = (unsigned short)f2bf(r);
        }
    } else if (tid >= 256) {
        const int t2 = tid - 256;
        bf16* GQD = (bf16*)(F.ws + WS_GQD) + (size_t)it * 8192;
        bf16* GKDT = (bf16*)(F.ws + WS_GKDT) + (size_t)it * 8192;
#pragma unroll
        for (int q = 0; q < 4; ++q) {
            const int ch = t2 + 256 * q, row = ch >> 4, c16 = ch & 15; const float e = scal[128 + row];
            const v4u u = *(const LAS v4u*)(L + P2_QT + row * P2_RS + 16 * c16);
            v4u o; o.x = pk2(bflo(u.x) * e, bfhi(u.x) * e); o.y = pk2(bflo(u.y) * e, bfhi(u.y) * e); o.z = pk2(bflo(u.z) * e, bfhi(u.z) * e); o.w = pk2(bflo(u.w) * e, bfhi(u.w) * e);
            *(GAS v4u*)(GQD + row * 128 + 8 * c16) = o;
        }
        {
            const int d = t2 >> 1, i0 = 32 * (t2 & 1);
#pragma unroll
            for (int q = 0; q < 4; ++q) {
                float v[8];
#pragma unroll
                for (int e = 0; e < 8; ++e) { const int i = i0 + 8 * q + e; v[e] = bf2f(*(const LAS unsigned short*)(L + P2_KT + i * P2_RS + 2 * d)) * scal[192 + i]; }
                v4u o; o.x = pk2(v[0], v[1]); o.y = pk2(v[2], v[3]); o.z = pk2(v[4], v[5]); o.w = pk2(v[6], v[7]);
                *(GAS v4u*)(GKDT + d * 64 + i0 + 8 * q) = o;
            }
        }
    }
    __syncthreads();

    {
        const int g = lane >> 4, c = lane & 15;
        const f32x4 z4 = {0.f, 0.f, 0.f, 0.f};
        if (wave < 4) p2_solve<true>(F, L, scal, it, wave, g, c); else p2_solve<false>(F, L, scal, it, wave, g, c);
    }
    __syncthreads();

}

__device__ __forceinline__ void p2_static(Frame& F, const Args& A) {
    int tid = F.tid; asm volatile("" : "+v"(tid));
    const int lane = tid & 63, wave = __builtin_amdgcn_readfirstlane(tid >> 6);
    P2Regs R;
    int it = F.vcu;
    if (it < NGITEM) p2_load_all(R, F, A, it, tid, wave, lane, true);
#pragma unroll 1
    for (; it < NGITEM; it += F.G) p2_body(F, A, it, it + F.G, R, tid);
}

constexpr int SC_WK = 0, SC_QD = 17408, SC_U0 = 34816, SC_KDT = 44032, SC_QK = 62464;
constexpr int SC_RS = 272, SC_RS2 = 144, SC_BUF = 71680;
__device__ __forceinline__ void scan_item(Frame& F, const Args& A, int bh, int half, bool samp) {
    int tid = F.tid; asm volatile("" : "+v"(tid));
    const int lane = tid & 63, wave = __builtin_amdgcn_readfirstlane(tid >> 6), g = lane >> 4, c = lane & 15;
    LAS unsigned char* L = F.lds;
    const int b = bh >> 2, h = bh & 3;
    const int nsteps = samp ? 1 : 32;
    const int it0 = samp ? 1024 + bh : bh * 32;
    const int row0 = samp ? MP + 16 * b : b * T;
    const int itlast = it0 + nsteps - 1;
    const bool helper = wave >= 4;
    const int dv0 = 64 * half + 16 * (wave & 3);
    const int ht = tid - 256;
    v4u preA[16], preB[16];
#define SCAN_LOAD(pre, itm) do { \
        const bf16* pwk = (const bf16*)(F.ws + WS_GWK) + (size_t)(itm) * 8192; const bf16* pqd = (const bf16*)(F.ws + WS_GQD) + (size_t)(itm) * 8192; \
        const bf16* pu0 = (const bf16*)(F.ws + WS_GU0) + (size_t)(itm) * 8192 + 64 * half; const bf16* pkd = (const bf16*)(F.ws + WS_GKDT) + (size_t)(itm) * 8192; \
        const bf16* pqk = (const bf16*)(F.ws + WS_GQK) + (size_t)(itm) * 4096; \
        _Pragma("unroll") for (int i = 0; i < 4; ++i) { pre[i] = *(const GAS v4u*)(pwk + 8 * (ht + 256 * i)); pre[4 + i] = *(const GAS v4u*)(pqd + 8 * (ht + 256 * i)); pre[10 + i] = *(const GAS v4u*)(pkd + 8 * (ht + 256 * i)); } \
        _Pragma("unroll") for (int i = 0; i < 2; ++i) { const int q = ht + 256 * i; pre[8 + i] = *(const GAS v4u*)(pu0 + (q >> 3) * 128 + 8 * (q & 7)); pre[14 + i] = *(const GAS v4u*)(pqk + 8 * q); } } while (0)
#define SCAN_ST2(dst, val_) do { LAS unsigned char* d_ = (dst); const v4u v_ = (val_); *(LAS v2u*)d_ = (v2u){v_.x, v_.y}; *(LAS v2u*)(d_ + 16) = (v2u){v_.z, v_.w}; } while (0)
#define SCAN_POFF(c_) (64 * ((c_) >> 2) + 8 * (4 * ((c_) & 1) + (((c_) & 3) >> 1)))
#define SCAN_STORE(pre, Lb) do { \
        _Pragma("unroll") for (int i = 0; i < 4; ++i) { const int q = ht + 256 * i, row = q >> 4, c16 = q & 15; \
            SCAN_ST2((Lb) + SC_WK + row * SC_RS + SCAN_POFF(c16), pre[i]); SCAN_ST2((Lb) + SC_QD + row * SC_RS + SCAN_POFF(c16), pre[4 + i]); \
            const int row2 = q >> 3, c8 = q & 7; SCAN_ST2((Lb) + SC_KDT + row2 * SC_RS2 + SCAN_POFF(c8), pre[10 + i]); } \
        _Pragma("unroll") for (int i = 0; i < 2; ++i) { const int q = ht + 256 * i, row2 = q >> 3, c8 = q & 7; \
            *(LAS v4u*)((Lb) + SC_U0 + row2 * SC_RS2 + 16 * c8) = pre[8 + i]; SCAN_ST2((Lb) + SC_QK + row2 * SC_RS2 + SCAN_POFF(c8), pre[14 + i]); } } while (0)
    if (helper) {
#define SCAN_CL(i_) ((i_) <= itlast ? (i_) : itlast)
        SCAN_LOAD(preA, it0);
        SCAN_LOAD(preB, SCAN_CL(it0 + 1));
        SCAN_STORE(preA, L);
        SCAN_LOAD(preA, SCAN_CL(it0 + 2));
        __syncthreads();
        for (int n = 0; n < nsteps; n += 2) {
            if (n + 1 < nsteps) SCAN_STORE(preB, L + SC_BUF);
            SCAN_LOAD(preB, SCAN_CL(it0 + n + 3));
            __syncthreads();
            if (n + 1 < nsteps) {
                if (n + 2 < nsteps) SCAN_STORE(preA, L);
                SCAN_LOAD(preA, SCAN_CL(it0 + n + 4));
                __syncthreads();
            }
        }
#undef SCAN_CL
    } else {
        f32x4 S[8];
        if (samp) {
            const float* s0 = A.in[3] + (size_t)bh * 16384;
#pragma unroll
            for (int t = 0; t < 8; ++t)
#pragma unroll
                for (int r = 0; r < 4; ++r) S[t][r] = s0[(16 * t + 4 * g + r) * 128 + dv0 + c];
        } else {
#pragma unroll
            for (int t = 0; t < 8; ++t) S[t] = (f32x4){0.f, 0.f, 0.f, 0.f};
        }
        float glv = ((const float*)(F.ws + WS_GLAST))[it0 + (lane < nsteps ? lane : nsteps - 1)];
#pragma unroll
        for (int t = 0; t < 8; ++t)
#pragma unroll
            for (int r = 0; r < 4; ++r) { float x = S[t][r]; asm volatile("" : "+v"(x)); S[t][r] = x; }
        asm volatile("" : "+v"(glv));
        float last = __builtin_bit_cast(float, __builtin_amdgcn_readlane(__builtin_bit_cast(int, glv), 0));
        unsigned short* op = (unsigned short*)(F.ws + WS_OA) + (size_t)(row0 + 4 * g) * 512 + h * 128 + dv0 + c;
        __syncthreads();
        for (int n = 0; n < nsteps; ++n) {
            const LAS unsigned char* Lc = L + (n & 1) * SC_BUF;
            const float lastn = __builtin_bit_cast(float, __builtin_amdgcn_readlane(__builtin_bit_cast(int, glv), n + 1 < nsteps ? n + 1 : nsteps - 1));
            bf16x8 BS[4];
#pragma unroll
            for (int ks = 0; ks < 4; ++ks) BS[ks] = acc_to_bfrag(S[2 * ks], S[2 * ks + 1]);
            f32x4 u[4], o[4];
#pragma unroll
            for (int tt = 0; tt < 4; ++tt) {
                bf16x8 af[8];
#pragma unroll
                for (int ks = 0; ks < 4; ++ks) { af[ks] = lds_frag16(Lc + SC_WK + (16 * tt + c) * SC_RS + 64 * ks + 16 * g); af[4 + ks] = lds_frag16(Lc + SC_QD + (16 * tt + c) * SC_RS + 64 * ks + 16 * g); }
#pragma unroll
                for (int r = 0; r < 4; ++r) u[tt][r] = bf2f(*(const LAS unsigned short*)(Lc + SC_U0 + (16 * tt + 4 * g + r) * SC_RS2 + 2 * (16 * (wave & 3) + c)));
                o[tt] = (f32x4){0.f, 0.f, 0.f, 0.f};
                __builtin_amdgcn_sched_barrier(0);
#pragma unroll
                for (int ks = 0; ks < 4; ++ks) { u[tt] = MFMA16(af[ks], BS[ks], u[tt]); o[tt] = MFMA16(af[4 + ks], BS[ks], o[tt]); }
                __builtin_amdgcn_sched_barrier(0);
            }
            bf16x8 BU[2];
            BU[0] = acc_to_bfrag(u[0], u[1]); BU[1] = acc_to_bfrag(u[2], u[3]);
            {
                bf16x8 af[8];
#pragma unroll
                for (int tt = 0; tt < 4; ++tt)
#pragma unroll
                    for (int k2 = 0; k2 < 2; ++k2) af[2 * tt + k2] = lds_frag16(Lc + SC_QK + (16 * tt + c) * SC_RS2 + 64 * k2 + 16 * g);
                __builtin_amdgcn_sched_barrier(0);
#pragma unroll
                for (int tt = 0; tt < 4; ++tt)
#pragma unroll
                    for (int k2 = 0; k2 < 2; ++k2) o[tt] = MFMA16(af[2 * tt + k2], BU[k2], o[tt]);
                __builtin_amdgcn_sched_barrier(0);
            }
#pragma unroll
            for (int th = 0; th < 2; ++th) {
                bf16x8 af[8];
#pragma unroll
                for (int t4 = 0; t4 < 4; ++t4)
#pragma unroll
                    for (int k2 = 0; k2 < 2; ++k2) af[2 * t4 + k2] = lds_frag16(Lc + SC_KDT + (16 * (4 * th + t4) + c) * SC_RS2 + 64 * k2 + 16 * g);
#pragma unroll
                for (int t4 = 0; t4 < 4; ++t4) S[4 * th + t4] = S[4 * th + t4] * last;
                __builtin_amdgcn_sched_barrier(0);
#pragma unroll
                for (int t4 = 0; t4 < 4; ++t4)
#pragma unroll
                    for (int k2 = 0; k2 < 2; ++k2) S[4 * th + t4] = MFMA16(af[2 * t4 + k2], BU[k2], S[4 * th + t4]);
                __builtin_amdgcn_sched_barrier(0);
            }
            last = lastn;
            if (!samp) {
#pragma unroll
                for (int tt = 0; tt < 4; ++tt)
#pragma unroll
                    for (int r = 0; r < 4; ++r) op[(size_t)(16 * tt + r) * 512] = (unsigned short)f2bf(o[tt][r]);
                op += (size_t)64 * 512;
            } else {
#pragma unroll
                for (int r = 0; r < 4; ++r) op[(size_t)r * 512] = (unsigned short)f2bf(o[0][r]);
            }
            __syncthreads();
        }
        float* so = F.out + (samp ? OFF_SSSM : OFF_PSSM) + (size_t)bh * 16384;
#pragma unroll
        for (int t = 0; t < 8; ++t)
#pragma unroll
            for (int r = 0; r < 4; ++r) so[(16 * t + 4 * g + r) * 128 + dv0 + c] = S[t][r];
    }
    asm volatile("s_waitcnt vmcnt(0)" ::: "memory");
    __syncthreads();
    if (tid == 0) {
        __builtin_amdgcn_fence(__ATOMIC_RELEASE, "agent");
        asm volatile("s_waitcnt vmcnt(0)" ::: "memory");
        __hip_atomic_fetch_add(F.ctl + CW_GATE + 64 * ((samp ? 32 : 0) + bh), 1u, __ATOMIC_RELAXED, __HIP_MEMORY_SCOPE_AGENT);
    }
    __syncthreads();
#undef SCAN_LOAD
#undef SCAN_STORE
#undef SCAN_ST2
#undef SCAN_POFF
}

__device__ __forceinline__ void gate_item(Frame& F, int bh, int part) {
    int tid = F.tid; asm volatile("" : "+v"(tid));
    const int lane = tid & 63, wave = __builtin_amdgcn_readfirstlane(tid >> 6);
    const int b = bh >> 2, h = bh & 3;
    const bool samp = part == 8;
    if (tid == 0) {
        gu32* flag = F.ctl + CW_GATE + 64 * ((samp ? 32 : 0) + bh);
        unsigned sp = 0;
        while (__hip_atomic_load(flag, RLX_AGENT) < 2u) {
            __builtin_amdgcn_s_sleep(2);
            if (++sp > (1u << 22)) { __hip_atomic_store(F.ctl + CW_TMO, 0x6a7eu, RLX_AGENT); break; }
        }
        __builtin_amdgcn_fence(__ATOMIC_ACQUIRE, "agent");
        asm volatile("s_waitcnt vmcnt(0)" ::: "memory");
    }
    __syncthreads();
    const bf16* OA = (const bf16*)(F.ws + WS_OA); const bf16* ZA = (const bf16*)(F.ws + WS_ZA); bf16* MIX = (bf16*)(F.ws + WS_MIX);
    const float* go = (const float*)(F.ws + WS_PAR) + PAR_GO;
    const float g0 = go[2 * lane], g1 = go[2 * lane + 1];
    const int row0 = samp ? MP + 16 * b : b * T + 256 * part;
    const int nrow = samp ? 2 : 32;
#pragma unroll 1
    for (int i0 = 0; i0 < nrow; i0 += 32) {
        float2 o[32]; unsigned z[32];
#pragma unroll
        for (int i = 0; i < 32; ++i) { const int row = row0 + wave * nrow + (i0 + i < nrow ? i0 + i : nrow - 1);
            { const unsigned ow = *(const unsigned*)(OA + (size_t)row * 512 + h * 128 + 2 * lane); o[i].x = bflo(ow); o[i].y = bfhi(ow); } z[i] = *(const unsigned*)(ZA + (size_t)row * 512 + h * 128 + 2 * lane); }
#pragma unroll
        for (int i = 0; i < 32; ++i) {
            float x = o[i].x * o[i].x + o[i].y * o[i].y;
            x += __builtin_bit_cast(float, __builtin_amdgcn_update_dpp(0, __builtin_bit_cast(int, x), 0x111, 0xf, 0xf, false));
            x += __builtin_bit_cast(float, __builtin_amdgcn_update_dpp(0, __builtin_bit_cast(int, x), 0x112, 0xf, 0xf, false));
            x += __builtin_bit_cast(float, __builtin_amdgcn_update_dpp(0, __builtin_bit_cast(int, x), 0x114, 0xf, 0xf, false));
            x += __builtin_bit_cast(float, __builtin_amdgcn_update_dpp(0, __builtin_bit_cast(int, x), 0x118, 0xf, 0xf, false));
            x += __builtin_bit_cast(float, __builtin_amdgcn_update_dpp(0, __builtin_bit_cast(int, x), 0x142, 0xa, 0xf, false));
            x += __builtin_bit_cast(float, __builtin_amdgcn_update_dpp(0, __builtin_bit_cast(int, x), 0x143, 0xc, 0xf, false));
            const float ss = __builtin_bit_cast(float, __builtin_amdgcn_readlane(__builtin_bit_cast(int, x), 63));
            const float rs = 1.0f / sqrtf(ss * (1.f / 128.f) + EPS);
            if (i0 + i < nrow) { const int row = row0 + wave * nrow + i0 + i;
                *(unsigned*)(MIX + (size_t)row * DM + h * 128 + 2 * lane) = pk2(o[i].x * rs * g0 * bflo(z[i]), o[i].y * rs * g1 * bfhi(z[i])); }
        }
    }
    __syncthreads();
}

__device__ __forceinline__ unsigned fkey(float f) { const unsigned u = __builtin_bit_cast(unsigned, f + 0.0f); return (u & 0x80000000u) ? ~u : (u | 0x80000000u); }
template <int S, unsigned M> __device__ __forceinline__ void tr_stage(unsigned (&a)[32]) {
#pragma unroll
    for (int k = 0; k < 32; ++k) if ((k & S) == 0) { const unsigned t = ((a[k] >> S) ^ a[k + S]) & M; a[k + S] ^= t; a[k] ^= t << S; }
}
__device__ __forceinline__ void transpose32(unsigned (&a)[32]) {
    tr_stage<16, 0x0000ffffu>(a); tr_stage<8, 0x00ff00ffu>(a); tr_stage<4, 0x0f0f0f0fu>(a); tr_stage<2, 0x33333333u>(a); tr_stage<1, 0x55555555u>(a);
}
__device__ __forceinline__ unsigned wave_total_u32(unsigned v) {
    int x = (int)v;
    x += __builtin_amdgcn_update_dpp(0, x, 0x111, 0xf, 0xf, false);
    x += __builtin_amdgcn_update_dpp(0, x, 0x112, 0xf, 0xf, false);
    x += __builtin_amdgcn_update_dpp(0, x, 0x114, 0xf, 0xf, false);
    x += __builtin_amdgcn_update_dpp(0, x, 0x118, 0xf, 0xf, false);
    x += __builtin_amdgcn_update_dpp(0, x, 0x142, 0xa, 0xf, false);
    x += __builtin_amdgcn_update_dpp(0, x, 0x143, 0xc, 0xf, false);
    return (unsigned)__builtin_amdgcn_readlane(x, 63);
}
__device__ __forceinline__ void transpose16x2(unsigned (&a)[16]) {
#define TR16_STAGE(S, M) _Pragma("unroll") for (int k = 0; k < 16; ++k) if ((k & S) == 0) { const unsigned t = ((a[k] >> S) ^ a[k + S]) & M; a[k + S] ^= t; a[k] ^= t << S; }
    TR16_STAGE(8, 0x00ff00ffu) TR16_STAGE(4, 0x0f0f0f0fu) TR16_STAGE(2, 0x33333333u) TR16_STAGE(1, 0x55555555u)
#undef TR16_STAGE
}
template <int NW, bool EXACT>
__device__ __forceinline__ void select_top256(const LAS float* sc, int n, int lane, unsigned (&sel)[NW]) {
    unsigned u[NW][32], alive[NW], gt[NW];
    const int niter = (n + 63) >> 6;
#pragma unroll
    for (int w = 0; w < NW; ++w) {
#pragma unroll
        for (int i = 0; i < 32; ++i) { const int e = 32 * w + i, idx = lane + 64 * e; u[w][i] = (e < niter && (EXACT || idx < n)) ? fkey(sc[idx]) : 0u; }
        unsigned valid = 0u;
        if (EXACT) { const int ne = niter - 32 * w; valid = ne >= 32 ? 0xffffffffu : (ne <= 0 ? 0u : (1u << ne) - 1u); }
        else {
#pragma unroll
            for (int i = 0; i < 32; ++i) { const int e = 32 * w + i; if (e < niter && lane + 64 * e < n) valid |= 1u << i; }
        }
        alive[w] = valid; gt[w] = 0u;
    }
    unsigned above = 0u, calive = (unsigned)n;
    bool done = false;
#pragma unroll
    for (int half = 1; half >= 0; --half) {
        if (!done) {
            unsigned P[NW][16];
#pragma unroll
            for (int w = 0; w < NW; ++w) {
#pragma unroll
                for (int k = 0; k < 16; ++k) P[w][k] = half ? ((u[w][k] >> 16) | (u[w][k + 16] & 0xffff0000u)) : ((u[w][k] & 0xffffu) | (u[w][k + 16] << 16));
                transpose16x2(P[w]);
            }
#pragma unroll
            for (int j = 15; j >= 0; --j) {
                if (!done) {
                    unsigned pc = 0u;
#pragma unroll
                    for (int w = 0; w < NW; ++w) pc += (unsigned)__builtin_popcount(alive[w] & P[w][j]);
                    const unsigned c1 = wave_total_u32(pc);
                    const bool one = above + c1 >= 256u;
                    if (one) calive = c1; else { above += c1; calive -= c1; }
#pragma unroll
                    for (int w = 0; w < NW; ++w) { const unsigned ones = alive[w] & P[w][j]; if (one) alive[w] = ones; else { gt[w] |= ones; alive[w] &= ~P[w][j]; } }
                    done = (calive + above == 256u);
                }
            }
        }
    }
    unsigned pc = 0u;
#pragma unroll
    for (int w = 0; w < NW; ++w) pc += (unsigned)__builtin_popcount(alive[w]);
    const unsigned nties = wave_total_u32(pc);
    unsigned rem = 256u - above;
    if (rem < nties) {
#pragma unroll
        for (int w = 0; w < NW; ++w)
#pragma unroll 1
            for (int i = 0; i < 32; ++i) {
                const bool mine = (alive[w] >> i) & 1u;
                const unsigned long long eq = __ballot(mine);
                const unsigned ce = (unsigned)__builtin_popcountll(eq);
                if (ce <= rem) rem -= ce;
                else { const unsigned rank = (unsigned)__builtin_popcountll(eq & ((1ull << lane) - 1ull)); if (mine && rank >= rem) alive[w] &= ~(1u << i); rem = 0u; }
            }
    }
#pragma unroll
    for (int w = 0; w < NW; ++w) sel[w] = gt[w] | alive[w];
}

__device__ __forceinline__ void select_top256_x2(const LAS float* sc0, const LAS float* sc1, int n, int lane, unsigned& sel0, unsigned& sel1) {
    unsigned u[2][32], alive[2], gt[2] = {0u, 0u}, above[2] = {0u, 0u}, calive[2];
    bool done[2] = {false, false};
    const int niter = n >> 6;
#pragma unroll
    for (int i = 0; i < 32; ++i) { const int idx = lane + 64 * i; u[0][i] = i < niter ? fkey(sc0[idx]) : 0u; u[1][i] = i < niter ? fkey(sc1[idx]) : 0u; }
    alive[0] = alive[1] = niter >= 32 ? 0xffffffffu : (1u << niter) - 1u;
    calive[0] = calive[1] = (unsigned)n;
#pragma unroll
    for (int half = 1; half >= 0; --half) {
        if (!(done[0] && done[1])) {
            unsigned P[2][16];
#pragma unroll
            for (int q = 0; q < 2; ++q) {
#pragma unroll
                for (int k = 0; k < 16; ++k) P[q][k] = half ? ((u[q][k] >> 16) | (u[q][k + 16] & 0xffff0000u)) : ((u[q][k] & 0xffffu) | (u[q][k + 16] << 16));
                transpose16x2(P[q]);
            }
#pragma unroll
            for (int j = 15; j >= 0; --j) {
                if (!(done[0] && done[1])) {
                    unsigned c1[2];
                    { const unsigned tot = wave_total_u32((unsigned)__builtin_popcount(alive[0] & P[0][j]) | ((unsigned)__builtin_popcount(alive[1] & P[1][j]) << 16));
                      c1[0] = tot & 0xffffu; c1[1] = tot >> 16; }
#pragma unroll
                    for (int q = 0; q < 2; ++q) if (!done[q]) {
                        const bool one = above[q] + c1[q] >= 256u;
                        if (one) calive[q] = c1[q]; else { above[q] += c1[q]; calive[q] -= c1[q]; }
                        const unsigned ones = alive[q] & P[q][j];
                        if (one) alive[q] = ones; else { gt[q] |= ones; alive[q] &= ~P[q][j]; }
                        done[q] = (calive[q] + above[q] == 256u);
                    }
                }
            }
        }
    }
    const unsigned nt2 = wave_total_u32((unsigned)__builtin_popcount(alive[0]) | ((unsigned)__builtin_popcount(alive[1]) << 16));
#pragma unroll
    for (int q = 0; q < 2; ++q) {
        const unsigned nties = q ? nt2 >> 16 : nt2 & 0xffffu;
        unsigned rem = 256u - above[q];
        if (rem < nties) {
#pragma unroll 1
            for (int i = 0; i < 32; ++i) {
                const bool mine = (alive[q] >> i) & 1u;
                const unsigned long long eq = __ballot(mine);
                const unsigned ce = (unsigned)__builtin_popcountll(eq);
                if (ce <= rem) rem -= ce;
                else { const unsigned rank = (unsigned)__builtin_popcountll(eq & ((1ull << lane) - 1ull)); if (mine && rank >= rem) alive[q] &= ~(1u << i); rem = 0u; }
            }
        }
    }
    sel0 = gt[0] | alive[0]; sel1 = gt[1] | alive[1];
}

constexpr int AT_RS = 544;
constexpr int AT_BUF = 64 * AT_RS;
constexpr int AT_K0 = 0, AT_V0 = 2 * AT_BUF;
constexpr int AT_SC = 0;
constexpr int AT_MASK = 4 * AT_BUF;
__device__ __forceinline__ void b1_item(Frame& F, const Args& A, int b, int cch, int sub) {
    int tid = F.tid; asm volatile("" : "+v"(tid));
    const int lane = tid & 63, wave = __builtin_amdgcn_readfirstlane(tid >> 6), g = lane >> 4, c = lane & 15;
    LAS unsigned char* L = F.lds;
    const int n = 64 * (cch + 1);
    const int q0 = b * T + 64 * cch + 16 * sub;
    const bf16* QI = (const bf16*)(F.ws + WS_QI); const bf16* KI = (const bf16*)(F.ws + WS_KI) + (size_t)b * T * 32;
    const float* SM = (const float*)(F.ws + WS_SMALL);
    LAS float* SCs = (LAS float*)(L + AT_SC);
    const int npair = n / 32;
    {
        bf16x8 qa[8];
#pragma unroll
        for (int h = 0; h < 8; ++h) qa[h] = *(const GAS bf16x8*)(QI + (size_t)(q0 + c) * 256 + h * 32 + 8 * g);
        float wq[4][8];
#pragma unroll
        for (int r = 0; r < 4; ++r) { const f32x4 w0 = *(const GAS f32x4*)(SM + (size_t)(q0 + 4 * g + r) * 16 + 8), w1 = *(const GAS f32x4*)(SM + (size_t)(q0 + 4 * g + r) * 16 + 12);
            wq[r][0] = 0.5f * w0[0]; wq[r][1] = 0.5f * w0[1]; wq[r][2] = 0.5f * w0[2]; wq[r][3] = 0.5f * w0[3]; wq[r][4] = 0.5f * w1[0]; wq[r][5] = 0.5f * w1[1]; wq[r][6] = 0.5f * w1[2]; wq[r][7] = 0.5f * w1[3]; }
        bf16x8 qlh, qll;
        {
            const f32x4 c0 = *(const GAS f32x4*)(SM + (size_t)(q0 + c) * 16 + 8), c1 = *(const GAS f32x4*)(SM + (size_t)(q0 + c) * 16 + 12);
            const float wc[8] = {0.5f * c0[0], 0.5f * c0[1], 0.5f * c0[2], 0.5f * c0[3], 0.5f * c1[0], 0.5f * c1[1], 0.5f * c1[2], 0.5f * c1[3]};
            float ql[8] = {0.f, 0.f, 0.f, 0.f, 0.f, 0.f, 0.f, 0.f};
#pragma unroll
            for (int h = 0; h < 8; ++h)
#pragma unroll
                for (int j = 0; j < 8; ++j) ql[j] += wc[h] * bf2f((unsigned short)qa[h][j]);
            float qh[8], qr[8];
#pragma unroll
            for (int j = 0; j < 8; ++j) { qh[j] = bf2f((unsigned short)f2bf(ql[j])); qr[j] = ql[j] - qh[j]; }
            v4u hw, lw;
            hw.x = pk2(qh[0], qh[1]); hw.y = pk2(qh[2], qh[3]); hw.z = pk2(qh[4], qh[5]); hw.w = pk2(qh[6], qh[7]);
            lw.x = pk2(qr[0], qr[1]); lw.y = pk2(qr[2], qr[3]); lw.z = pk2(qr[4], qr[5]); lw.w = pk2(qr[6], qr[7]);
            qlh = __builtin_bit_cast(bf16x8, hw); qll = __builtin_bit_cast(bf16x8, lw);
        }
        bf16x8 kn0 = *(const GAS bf16x8*)(KI + (size_t)(32 * wave + c) * 32 + 8 * g), kn1 = *(const GAS bf16x8*)(KI + (size_t)(32 * wave + 16 + c) * 32 + 8 * g);
        for (int kp = wave; kp < npair; kp += 8) {
            const bf16x8 k0 = kn0, k1 = kn1;
            { const int kq = kp + 8 < npair ? kp + 8 : kp; kn0 = *(const GAS bf16x8*)(KI + (size_t)(32 * kq + c) * 32 + 8 * g); kn1 = *(const GAS bf16x8*)(KI + (size_t)(32 * kq + 16 + c) * 32 + 8 * g); }
            f32x4 s0 = MFMA16(qlh, k0, ((f32x4){0.f, 0.f, 0.f, 0.f})), s1 = MFMA16(qlh, k1, ((f32x4){0.f, 0.f, 0.f, 0.f}));
            s0 = MFMA16(qll, k0, s0); s1 = MFMA16(qll, k1, s1);
#pragma unroll
            for (int h = 0; h < 8; ++h) {
                const f32x4 l0 = MFMA16(qa[h], k0, ((f32x4){0.f, 0.f, 0.f, 0.f})), l1 = MFMA16(qa[h], k1, ((f32x4){0.f, 0.f, 0.f, 0.f}));
#pragma unroll
                for (int r = 0; r < 4; ++r) { s0[r] = __builtin_fmaf(wq[r][h], __builtin_fabsf(l0[r]), s0[r]); s1[r] = __builtin_fmaf(wq[r][h], __builtin_fabsf(l1[r]), s1[r]); }
            }
#pragma unroll
            for (int r = 0; r < 4; ++r) { SCs[(4 * g + r) * 2048 + 32 * kp + c] = s0[r]; SCs[(4 * g + r) * 2048 + 32 * kp + 16 + c] = s1[r]; }
        }
    }
    __syncthreads();
    unsigned* SELW = (unsigned*)(F.ws + WS_SELW);
    {
        unsigned s0, s1;
        select_top256_x2(SCs + (2 * wave) * 2048, SCs + (2 * wave + 1) * 2048, n, lane, s0, s1);
        SELW[(size_t)(q0 + 2 * wave) * 64 + lane] = s0; SELW[(size_t)(q0 + 2 * wave + 1) * 64 + lane] = s1;
    }
    __syncthreads();
}
template <bool SAMP, bool ISB>
__device__ __forceinline__ void attn_item(Frame& F, const Args& A, int b, int qt, int half) {
    constexpr bool isB = ISB;
    int tid = F.tid; asm volatile("" : "+v"(tid));
    const int lane = tid & 63, wave = __builtin_amdgcn_readfirstlane(tid >> 6), g = lane >> 4, c = lane & 15;
    LAS unsigned char* L = F.lds;
    const int qrow0 = SAMP ? MP + 16 * b : b * T + 64 * qt;
    const int n = isB ? 64 * (qt + 1) : 256;
    LAS unsigned* selw = (LAS unsigned*)(L + AT_MASK);
    if (isB) {
        const v4u* src = (const v4u*)((const unsigned*)(F.ws + WS_SELW) + (size_t)qrow0 * 64);
#pragma unroll
        for (int i = 0; i < 2; ++i) { const v4u w = n > 256 ? src[tid + 512 * i] : (v4u){0xfu, 0xfu, 0xfu, 0xfu}; *(LAS v4u*)(selw + 4 * (tid + 512 * i)) = w; }
    }
    const int hh = wave & 3, qh = wave >> 2;
    const int nq2 = half == 2 ? 2 : 1;
    const int qoff0 = half == 2 ? 32 * qh : 32 * half + 16 * qh;
    const bf16* Qb = (const bf16*)(F.ws + (isB ? WS_QB : WS_QM));
    const bf16* Kb = isB ? (const bf16*)(F.ws + WS_KB) + (size_t)b * T * 256 : (const bf16*)(F.ws + WS_MEMK) + (size_t)b * 256 * 256;
    const bf16* Vb = isB ? (const bf16*)(F.ws + WS_VB) + (size_t)b * T * 256 : (const bf16*)(F.ws + WS_MEMV) + (size_t)b * 256 * 256;
    float bnd = ((const float*)(F.ws + WS_PAR))[isB ? PAR_BNDB : PAR_BNDC];
    const float* Kf = A.in[7] + (size_t)b * 65536; const float* Vf = A.in[8] + (size_t)b * 65536;
    if constexpr (SAMP) {
        float mx = 0.f;
#pragma unroll
        for (int i = 0; i < 4; ++i) {
            const float* kr = Kf + (size_t)((tid >> 3) + 64 * i) * 256 + 32 * (tid & 7);
            float ss = 0.f;
#pragma unroll
            for (int j = 0; j < 8; ++j) { const f32x4 x = *(const GAS f32x4*)(kr + 4 * j); ss += (x[0] * x[0] + x[1] * x[1]) + (x[2] * x[2] + x[3] * x[3]); }
            ss += __shfl_xor(ss, 1);
            mx = fmaxf(mx, ss);
        }
#pragma unroll
        for (int o = 2; o < 64; o <<= 1) mx = fmaxf(mx, __shfl_xor(mx, o));
        if (lane == 0) ((LAS float*)selw)[wave] = mx;
        __syncthreads();
#pragma unroll
        for (int w = 0; w < 8; ++w) mx = fmaxf(mx, ((LAS float*)selw)[w]);
        bnd = 1.01f * 1.4426950408889634f * ((const float*)(F.ws + WS_PAR))[PAR_GQMX] * sqrtf(mx);
    }
    constexpr float SCL = 0.125f * 1.4426950408889634f;
    bf16x8 qf[2][2];
#pragma unroll
    for (int q2 = 0; q2 < 2; ++q2)
#pragma unroll
        for (int ks = 0; ks < 2; ++ks) {
            const v4u qw = *(const GAS v4u*)(Qb + (size_t)(qrow0 + qoff0 + 16 * (q2 < nq2 ? q2 : 0) + c) * 256 + hh * 64 + 32 * ks + 8 * g);
            v4u qs; qs.x = pk2(bflo(qw.x) * SCL, bfhi(qw.x) * SCL); qs.y = pk2(bflo(qw.y) * SCL, bfhi(qw.y) * SCL); qs.z = pk2(bflo(qw.z) * SCL, bfhi(qw.z) * SCL); qs.w = pk2(bflo(qw.w) * SCL, bfhi(qw.w) * SCL);
            qf[q2][ks] = __builtin_bit_cast(bf16x8, qs);
        }
    const bf16x8 ones = __builtin_bit_cast(bf16x8, (v4u){0x3f803f80u, 0x3f803f80u, 0x3f803f80u, 0x3f803f80u});
    const f32x4 nbnd = {-bnd, -bnd, -bnd, -bnd};
    f32x4 lacc[2] = {{0.f, 0.f, 0.f, 0.f}, {0.f, 0.f, 0.f, 0.f}};
    f32x4 ot[2][4];
#pragma unroll
    for (int q2 = 0; q2 < 2; ++q2)
#pragma unroll
        for (int dt = 0; dt < 4; ++dt) ot[q2][dt] = (f32x4){0.f, 0.f, 0.f, 0.f};
    const int nblk = n / 64;
    v4u pk[4], pv[4];
    f32x4 rk[SAMP ? 4 : 1][2], rv[SAMP ? 4 : 1][2];
#define AT_LOAD(blk) do { _Pragma("unroll") for (int i = 0; i < 4; ++i) { const int q = tid + 512 * i, row = q >> 5, c16 = q & 31; \
        if constexpr (SAMP) { const float* kp_ = Kf + (size_t)(64 * (blk) + row) * 256 + 8 * c16; const float* vp_ = Vf + (size_t)(64 * (blk) + row) * 256 + 8 * c16; \
            rk[SAMP ? i : 0][0] = *(const GAS f32x4*)kp_; rk[SAMP ? i : 0][1] = *(const GAS f32x4*)(kp_ + 4); rv[SAMP ? i : 0][0] = *(const GAS f32x4*)vp_; rv[SAMP ? i : 0][1] = *(const GAS f32x4*)(vp_ + 4); } \
        else { pk[i] = *(const GAS v4u*)(Kb + (size_t)(64 * (blk) + row) * 256 + 8 * c16); pv[i] = *(const GAS v4u*)(Vb + (size_t)(64 * (blk) + row) * 256 + 8 * c16); } } } while (0)
#define AT_STORE(buf) do { _Pragma("unroll") for (int i = 0; i < 4; ++i) { const int q = tid + 512 * i, row = q >> 5, c16 = q & 31; \
        if constexpr (SAMP) { pk[i] = pack8(rk[SAMP ? i : 0][0], rk[SAMP ? i : 0][1]); pv[i] = pack8(rv[SAMP ? i : 0][0], rv[SAMP ? i : 0][1]); } \
        *(LAS v4u*)(L + AT_K0 + (buf) * AT_BUF + row * AT_RS + 16 * c16) = pk[i]; *(LAS v4u*)(L + AT_V0 + (buf) * AT_BUF + row * AT_RS + 16 * c16) = pv[i]; } } while (0)
    AT_LOAD(0);
    AT_STORE(0);
    AT_LOAD(nblk > 1 ? 1 : 0);
    __syncthreads();
    for (int kb = 0; kb < nblk; ++kb) {
        const int buf = kb & 1;
        const LAS unsigned char* Kp = L + AT_K0 + buf * AT_BUF; const LAS unsigned char* Vp = L + AT_V0 + buf * AT_BUF;
        if (kb + 1 < nblk) {
            AT_STORE(buf ^ 1);
            AT_LOAD(kb + 2 < nblk ? kb + 2 : kb + 1);
        }
        bf16x8 kf[4][2];
#pragma unroll
        for (int k2 = 0; k2 < 4; ++k2)
#pragma unroll
            for (int ks = 0; ks < 2; ++ks) kf[k2][ks] = lds_frag16(Kp + (16 * k2 + c) * AT_RS + 2 * (hh * 64 + 32 * ks + 8 * g));
        v4u mw[2][4];
#pragma unroll
        for (int q2 = 0; q2 < 2; ++q2)
#pragma unroll
            for (int k2 = 0; k2 < 4; ++k2) mw[q2][k2] = isB ? *(const LAS v4u*)(selw + (qoff0 + 16 * (q2 < nq2 ? q2 : 0) + c) * 64 + 16 * k2 + 4 * g) : (v4u){~0u, ~0u, ~0u, ~0u};
        __builtin_amdgcn_sched_barrier(0);
        f32x4 st[2][4];
#pragma unroll
        for (int q2 = 0; q2 < 2; ++q2) if (q2 < nq2)
#pragma unroll
            for (int k2 = 0; k2 < 4; ++k2) {
                st[q2][k2] = MFMA16(kf[k2][0], qf[q2][0], nbnd);
                st[q2][k2] = MFMA16(kf[k2][1], qf[q2][1], st[q2][k2]);
            }
        __builtin_amdgcn_sched_barrier(0);
        s16x4 vf[4][4];
#pragma unroll
        for (int dt = 0; dt < 4; ++dt) {
            const LAS unsigned char* va = Vp + (4 * g + (c >> 2)) * AT_RS + 2 * (hh * 64 + 16 * dt + 4 * (c & 3));
#pragma unroll
            for (int j = 0; j < 4; ++j) vf[dt][j] = __builtin_bit_cast(s16x4, __builtin_amdgcn_ds_read_tr16_b64_v4i16((LAS v4i16_t*)(va + 16 * j * AT_RS)));
        }
        bf16x8 pb[2][2];
#pragma unroll
        for (int q2 = 0; q2 < 2; ++q2) if (q2 < nq2) {
#pragma unroll
            for (int k2 = 0; k2 < 4; ++k2)
#pragma unroll
                for (int r = 0; r < 4; ++r) {
                    if (ISB) { const unsigned m = (unsigned)__builtin_amdgcn_sbfe((int)mw[q2][k2][r], kb, 1);
                        st[q2][k2][r] = __builtin_bit_cast(float, __builtin_bit_cast(unsigned, fexp2(st[q2][k2][r])) & m); }
                    else st[q2][k2][r] = fexp2(st[q2][k2][r]); }
            pb[q2][0] = acc_to_bfrag(st[q2][0], st[q2][1]); pb[q2][1] = acc_to_bfrag(st[q2][2], st[q2][3]);
        }
        __builtin_amdgcn_sched_barrier(0);
#pragma unroll
        for (int q2 = 0; q2 < 2; ++q2) if (q2 < nq2) { lacc[q2] = MFMA16(ones, pb[q2][0], lacc[q2]); lacc[q2] = MFMA16(ones, pb[q2][1], lacc[q2]); }
#pragma unroll
        for (int dt = 0; dt < 4; ++dt)
#pragma unroll
            for (int q2 = 0; q2 < 2; ++q2) if (q2 < nq2) {
                ot[q2][dt] = MFMA16(cat44(vf[dt][0], vf[dt][1]), pb[q2][0], ot[q2][dt]);
                ot[q2][dt] = MFMA16(cat44(vf[dt][2], vf[dt][3]), pb[q2][1], ot[q2][dt]);
            }
        __builtin_amdgcn_sched_barrier(0);
        __syncthreads();
    }
    const bf16* Zb = (const bf16*)(F.ws + (isB ? WS_ZB : WS_ZM));
    bf16* MIX = (bf16*)(F.ws + WS_MIX);
    v2u zz[2][4];
#pragma unroll
    for (int q2 = 0; q2 < 2; ++q2)
#pragma unroll
        for (int dt = 0; dt < 4; ++dt) {
            const size_t row = (size_t)(qrow0 + qoff0 + 16 * (q2 < nq2 ? q2 : 0) + c);
            zz[q2][dt] = *(const GAS v2u*)(Zb + row * 256 + hh * 64 + 16 * dt + 4 * g);
        }
#pragma unroll
    for (int q2 = 0; q2 < 2; ++q2) if (q2 < nq2 && !(SAMP && qh != 0)) {
        const float inv = frcp(lacc[q2][0]);
        const size_t row = (size_t)(qrow0 + qoff0 + 16 * q2 + c);
#pragma unroll
        for (int dt = 0; dt < 4; ++dt) {
            const int col = hh * 64 + 16 * dt + 4 * g;
            const v2u z = zz[q2][dt];
            v2u o; o.x = pk2(ot[q2][dt][0] * inv * bflo(z.x), ot[q2][dt][1] * inv * bfhi(z.x)); o.y = pk2(ot[q2][dt][2] * inv * bflo(z.y), ot[q2][dt][3] * inv * bfhi(z.y));
            *(GAS v2u*)(MIX + row * DM + (isB ? 512 : 768) + col) = o;
        }
    }
#undef AT_LOAD
#undef AT_STORE
}

constexpr int SP_SC = 0;
constexpr int SP_Q = 20480;
constexpr int SP_LIST = 24576;
constexpr int SP_COMB = 28672;
constexpr int SP_CBUF = 40960;
__device__ __forceinline__ void sample_gather_attn(Frame& F, int row, const LAS int* list, const float* kold, const float* vold, const float* knew, const float* vnew, int nold,
                                                   const bf16* Qb, const bf16* Zb, int mixcol) {
    int tid = F.tid; asm volatile("" : "+v"(tid));
    const int lane = tid & 63, wave = __builtin_amdgcn_readfirstlane(tid >> 6);
    LAS unsigned char* L = F.lds;
    const v2u qw = *(const GAS v2u*)(Qb + (size_t)row * 256 + 4 * lane);
    const f32x4 q = {bflo(qw.x), bfhi(qw.x), bflo(qw.y), bfhi(qw.y)};
    float m = -1e30f, l = 0.f; f32x4 o = {0.f, 0.f, 0.f, 0.f};
#pragma unroll 1
    for (int i0 = 0; i0 < 32; i0 += 16) {
        f32x4 kv[16], vv[16];
#pragma unroll
        for (int j = 0; j < 16; ++j) { const int s = list[32 * wave + i0 + j];
            const float* kp = s < nold ? kold + (size_t)s * 256 : knew + (size_t)(s - nold) * 256; const float* vp = s < nold ? vold + (size_t)s * 256 : vnew + (size_t)(s - nold) * 256;
            kv[j] = *(const GAS f32x4*)(kp + 4 * lane); vv[j] = *(const GAS f32x4*)(vp + 4 * lane); }
#pragma unroll
        for (int j = 0; j < 16; ++j) {
            float d = (q[0] * kv[j][0] + q[1] * kv[j][1]) + (q[2] * kv[j][2] + q[3] * kv[j][3]);
            d += __builtin_bit_cast(float, __builtin_amdgcn_update_dpp(0, __builtin_bit_cast(int, d), 0x128, 0xf, 0xf, false));
            d += __builtin_bit_cast(float, __builtin_amdgcn_update_dpp(0, __builtin_bit_cast(int, d), 0x124, 0xf, 0xf, false));
            d += __builtin_bit_cast(float, __builtin_amdgcn_update_dpp(0, __builtin_bit_cast(int, d), 0x122, 0xf, 0xf, false));
            d += __builtin_bit_cast(float, __builtin_amdgcn_update_dpp(0, __builtin_bit_cast(int, d), 0x121, 0xf, 0xf, false));
            const float sc_ = d * 0.125f; const float mn = fmaxf(m, sc_), al = expf(m - mn), p = expf(sc_ - mn);
            m = mn; l = l * al + p; o = o * al + vv[j] * p;
        }
    }
    LAS float* comb = (LAS float*)(L + SP_COMB) + wave * 264;
    if ((lane & 15) == 0) { comb[lane >> 4] = m; comb[4 + (lane >> 4)] = l; }
    *(LAS f32x4*)(comb + 8 + 4 * lane) = o;
    __syncthreads();
    if (tid < 256) {
        const int hd = tid >> 6; const LAS float* cb = (const LAS float*)(L + SP_COMB);
        float M = -1e30f;
#pragma unroll
        for (int w = 0; w < 8; ++w) M = fmaxf(M, cb[w * 264 + hd]);
        float Ls = 0.f, O = 0.f;
#pragma unroll
        for (int w = 0; w < 8; ++w) { const float e = expf(cb[w * 264 + hd] - M); Ls += cb[w * 264 + 4 + hd] * e; O += cb[w * 264 + 8 + tid] * e; }
        const float z = bf2f(Zb[(size_t)row * 256 + tid]);
        ((bf16*)(F.ws + WS_MIX))[(size_t)row * DM + mixcol + tid] = (bf16)f2bf(O / Ls * z);
    }
    __syncthreads();
}
constexpr int S4_SC = 0;
constexpr int S4_LIST = 66560;
constexpr int S4_COMB = 70656;
__device__ __forceinline__ void sample_sel_item(Frame& F, const Args& A, int qg) {
    int tid = F.tid; asm volatile("" : "+v"(tid));
    const int lane = tid & 63, wave = __builtin_amdgcn_readfirstlane(tid >> 6), g = lane >> 4, c = lane & 15;
    LAS unsigned char* L = F.lds;
    const int b = qg >> 2, row0 = MP + 4 * qg;
    constexpr int NK = PAST + ST;
    LAS float* SCs = (LAS float*)(L + S4_SC); LAS int* list = (LAS int*)(L + S4_LIST);
    {
        bf16x8 qa[2]; f32x4 wv[2];
#pragma unroll
        for (int p = 0; p < 2; ++p) {
            qa[p] = *(const GAS bf16x8*)((const bf16*)(F.ws + WS_QI) + (size_t)(row0 + 2 * p + (c >> 3)) * 256 + (c & 7) * 32 + 8 * g);
            wv[p] = *(const GAS f32x4*)((const float*)(F.ws + WS_SMALL) + (size_t)(row0 + 2 * p + (g >> 1)) * 16 + 8 + 4 * (g & 1));
        }
        const float* kiold = A.in[6] + (size_t)b * PAST * 32; const float* kinew = F.out + OFF_SKI + (size_t)b * ST * 32;
        constexpr int NT = NK / 16;
        f32x4 nx[4][2];
#pragma unroll
        for (int j = 0; j < 4; ++j) { int kq = wave + 8 * j; kq = kq < NT ? kq : NT - 1; const float* kp = (kq < 256 ? kiold + (size_t)(16 * kq + c) * 32 : kinew + (size_t)c * 32) + 8 * g; nx[j][0] = *(const GAS f32x4*)kp; nx[j][1] = *(const GAS f32x4*)(kp + 4); }
#pragma unroll 1
        for (int kt0 = wave; kt0 < NT; kt0 += 32) {
            f32x4 cu[4][2];
#pragma unroll
            for (int j = 0; j < 4; ++j) { cu[j][0] = nx[j][0]; cu[j][1] = nx[j][1]; }
#pragma unroll
            for (int j = 0; j < 4; ++j) { int kq = kt0 + 32 + 8 * j; kq = kq < NT ? kq : NT - 1; const float* kp = (kq < 256 ? kiold + (size_t)(16 * kq + c) * 32 : kinew + (size_t)c * 32) + 8 * g; nx[j][0] = *(const GAS f32x4*)kp; nx[j][1] = *(const GAS f32x4*)(kp + 4); }
#pragma unroll
            for (int j = 0; j < 4; ++j) {
                const int kt = kt0 + 8 * j;
                const bf16x8 kb = __builtin_bit_cast(bf16x8, pack8(cu[j][0], cu[j][1]));
#pragma unroll
                for (int p = 0; p < 2; ++p) {
                    const f32x4 lg = MFMA16(qa[p], kb, ((f32x4){0.f, 0.f, 0.f, 0.f}));
                    float sc = (wv[p][0] * fmaxf(lg[0], 0.f) + wv[p][1] * fmaxf(lg[1], 0.f)) + (wv[p][2] * fmaxf(lg[2], 0.f) + wv[p][3] * fmaxf(lg[3], 0.f));
                    sc += __shfl_xor(sc, 16);
                    if ((g & 1) == 0 && kt < NT) SCs[(2 * p + (g >> 1)) * 4160 + 16 * kt + c] = sc;
                }
            }
        }
    }
    __syncthreads();
    if (wave < 4) {
        unsigned sl[3];
        select_top256<3, false>(SCs + wave * 4160, NK, lane, sl);
        int base = 0;
#pragma unroll
        for (int w = 0; w < 3; ++w)
#pragma unroll 1
            for (int i = 0; i < 32; ++i) {
                const int e = 32 * w + i; if (e >= 65) break;
                const bool mine = (sl[w] >> i) & 1u;
                const unsigned long long bm = __ballot(mine);
                if (mine) { const int pos = base + (int)__builtin_popcountll(bm & ((1ull << lane) - 1ull)); if (pos < 256) list[wave * 256 + pos] = lane + 64 * e; }
                base += (int)__builtin_popcountll(bm);
            }
    }
    __syncthreads();
    { int* LG = (int*)(F.ws + WS_SLIST) + (size_t)(4 * qg) * 256; LG[tid] = list[tid]; LG[512 + tid] = list[512 + tid]; }
    __syncthreads();
}
__device__ __forceinline__ void sample_bg_item(Frame& F, const Args& A, int qs) {
    const int b = qs >> 4, row = MP + qs;
    LAS int* list = (LAS int*)(F.lds + SP_LIST);
    if (F.tid < 256) list[F.tid] = ((const int*)(F.ws + WS_SLIST))[(size_t)qs * 256 + F.tid];
    __syncthreads();
    sample_gather_attn(F, row, list, A.in[4] + (size_t)b * PAST * 256, A.in[5] + (size_t)b * PAST * 256, F.out + OFF_SK + (size_t)b * ST * 256, F.out + OFF_SV + (size_t)b * ST * 256, PAST,
                       (const bf16*)(F.ws + WS_QB), (const bf16*)(F.ws + WS_ZB), 512);
}

constexpr int Q2_SS = 32, Q2_B1 = 28 * 32;
constexpr int Q2_TOTAL = Q2_SS + Q2_B1;
constexpr int Q_SCAN = 64, Q_B = 256, Q_SB = 128, Q_C = 256, Q_SC = 8, Q_SS = 64, Q_G = 32 * 9;
constexpr int Q_TOTAL = Q_SCAN + Q_B + Q_SB + Q_C + Q_SC + Q_SS + Q_G;
__device__ __forceinline__ void work_phase(Frame& F, const Args& A, int qword, bool second) {
    volatile LAS int* slot = (volatile LAS int*)(F.MISC + 16);
    const int total = second ? Q_TOTAL : Q2_TOTAL;
    const int batch = 1;
    for (int jb = 0, jn = 0;;) {
        if (jn == 0) {
            if (F.tid == 0) slot[0] = (int)__hip_atomic_fetch_add(F.ctl + qword, (unsigned)batch, __ATOMIC_RELAXED, __HIP_MEMORY_SCOPE_AGENT);
            __syncthreads();
            jb = slot[0]; jn = batch;
            __syncthreads();
        }
        int j = jb++; --jn;
        if (j >= total) break;
        int kind, p0 = 0, p1 = 0, p2 = 0; bool flag = false;
        if (!second) {
            if (j < Q2_SS) { kind = 7; p0 = j; }
            else { j -= Q2_SS; kind = 5; p0 = (j & 31) >> 2; p1 = 31 - (j >> 5); p2 = j & 3; }
        } else {
            if (j < Q_SCAN) { kind = 0; p0 = j; flag = false; }
            else if ((j -= Q_SCAN) < Q_SC) { kind = 3; p0 = j; }
            else if ((j -= Q_SC) < Q_B) { kind = 1; p0 = j & 7; p1 = 31 - (j >> 3); flag = true; }
            else if ((j -= Q_B) < Q_SB) { kind = 2; p0 = j; }
            else if ((j -= Q_SB) < Q_SS) { kind = 0; p0 = j; flag = true; }
            else if ((j -= Q_SS) < Q_G) { kind = 4; p0 = j / 9; p1 = j % 9; }
            else { j -= Q_G; kind = 1; p0 = j >> 5; p1 = j & 31; flag = false; }
        }
        if (kind == 0) scan_item(F, A, p0 >> 1, p0 & 1, flag);
        else if (kind == 1) { if (flag) attn_item<false, true>(F, A, p0, p1, 2); else attn_item<false, false>(F, A, p0, p1, 2); }
        else if (kind == 2) sample_bg_item(F, A, p0);
        else if (kind == 3) attn_item<true, false>(F, A, p0, 0, 0);
        else if (kind == 4) gate_item(F, p0, p1);
        else if (kind == 5) b1_item(F, A, p0, p1, p2);
        else sample_sel_item(F, A, p0);
    }
}
__device__ __forceinline__ void p2_phase(Frame& F, const Args& A, int qword = CW_Q1) { work_phase(F, A, qword, false); }
__device__ __forceinline__ void p3_phase(Frame& F, const Args& A, int qword = CW_Q0) { work_phase(F, A, qword, true); }

__global__ void __launch_bounds__(NWAVES * 64, 2) mk_fwd(Args args) {
    extern __shared__ __attribute__((aligned(16))) unsigned char lds[];
    Frame F;
    F.lds = (LAS unsigned char*)lds;
    F.MISC = (volatile LAS unsigned*)(F.lds + MISC_OFF);
    F.tid = threadIdx.x; F.lane = F.tid & 63; F.wave = __builtin_amdgcn_readfirstlane(F.tid >> 6);
    F.G = gridDim.x; { const int bx = blockIdx.x; F.vcu = (F.G % 8 == 0) ? (bx % 8) * (F.G / 8) + bx / 8 : bx; }
    F.out = args.out; F.ws = args.ws; F.ctl = (gu32*)(args.ws + WS_CTL);
    for (int u = F.tid; u < (LDS_BYTES - LDSCTL_OFF) / 4; u += NWAVES * 64) ((LAS unsigned*)(F.lds + LDSCTL_OFF))[u] = 0u;
    __syncthreads();
    XcdBarrier bar; bar.bar = (unsigned*)(F.ctl + CW_BAR) + args.li * XCD_BAR_WORDS; bar.x = 0; bar.st = nullptr;
    if (N_LAUNCHES != PER_PHASE) bar = xcd_barrier_post((unsigned*)(F.ctl + CW_BAR) + args.li * XCD_BAR_WORDS, F.MISC + 8);
#define GRID_BAR(seam) do { if (N_LAUNCHES == PER_PHASE) { if (F.tid == 0) __hip_atomic_store(F.ctl + CW_TMO, 0xBADBA0u | (unsigned)(seam), RLX_AGENT); } else { xcd_barrier(bar); } } while (0)
    const int lo = args.ph_lo, hi = args.ph_hi;
#define IN(k) (lo <= (k) && (k) < hi)
#define BOTH(k) (IN(k) && IN((k) + 1))

    if (IN(0)) { p0_prologue(F, args);
        if (BOTH(0)) GRID_BAR(0); }

    if (IN(1)) {
        pg8::Gemm g{(const bf16*)(F.ws + WS_XN), (const bf16*)(F.ws + WS_WIN), MALL, NALL, DM}; InOrder S; S.init(F.G, (int)blockIdx.x);
        EpiIn E{F.ws, F.out};
        if ((int)blockIdx.x >= 207) {
            small_stage_w(F.ws, F.lds + LDS_MAIN, F.tid);
            __syncthreads();
            for (int it = (int)blockIdx.x - 207; it < 129; it += 49) small_item(F.ws, F.out, F.lds + LDS_MAIN, 128 * it, F.tid);
            __syncthreads();
        }
        pg8::gemm_phase<EpiIn, InOrder, true, true>(F.lds + LDS_MAIN, g, S, E);
        if (BOTH(1)) GRID_BAR(1);

    }

    if (IN(2)) {
        if (blockIdx.x < 16) {
            pg8::Gemm g{(const bf16*)(F.ws + WS_XN), (const bf16*)(F.ws + WS_WIN), MALL, NALL, DM}; MemOrder S{(int)blockIdx.x};
            EpiIn E{F.ws, F.out};
            pg8::gemm_phase<EpiIn, MemOrder, true, true>(F.lds + LDS_MAIN, g, S, E);
            __syncthreads();
        }
        p2_static(F, args);
        p2_phase(F, args);
        if (BOTH(2)) GRID_BAR(2); }

    if (IN(3)) { p3_phase(F, args);
        if (BOTH(3)) GRID_BAR(3); }


    if (IN(5)) {
        pg8::Gemm g{(const bf16*)(F.ws + WS_MIX), (const bf16*)(F.ws + WS_WOUT), MP, DM, DM}; pg8::StaticOrder S; S.init(MP, DM, F.G, (int)blockIdx.x);
        EpiOut E{args.in[0], args.in[1], F.out};
        if (blockIdx.x < 64) sample_out_item(F.ws, args.in[1], F.out, (int)blockIdx.x, F.tid);
        pg8::gemm_phase<EpiOut, pg8::StaticOrder, true, true>(F.lds + LDS_MAIN, g, S, E);
    }
#undef IN
#undef BOTH
}

extern "C" void kernel_launch(void* const* d_in, const int* in_sizes, int n_in, void* d_out, int out_size, void* d_ws, size_t ws_size, hipStream_t stream) {
    static int grid = 0;
    if (grid == 0) {
        if (n_in != 24 || in_sizes[0] != MP * DM || out_size != (int)OUT_TOTAL || ws_size < WS_END) {
            fprintf(stderr, "kernel_launch: unexpected shapes: n_in %d in0 %d out %d ws %zu (need %zu)\n", n_in, n_in > 0 ? in_sizes[0] : -1, out_size, ws_size, (size_t)WS_END); grid = -1; return; }
        int dev = 0, cus = 0, per_cu = 0;
        if (hipGetDevice(&dev) != hipSuccess || hipDeviceGetAttribute(&cus, hipDeviceAttributeMultiprocessorCount, dev) != hipSuccess) { grid = -1; return; }
        if (hipFuncSetAttribute((const void*)mk_fwd, hipFuncAttributeMaxDynamicSharedMemorySize, LDS_BYTES) != hipSuccess) { fprintf(stderr, "kernel_launch: hipFuncSetAttribute failed\n"); grid = -1; return; }
        if (hipOccupancyMaxActiveBlocksPerMultiprocessor(&per_cu, (const void*)mk_fwd, NWAVES * 64, LDS_BYTES) != hipSuccess || per_cu < 1)
            fprintf(stderr, "kernel_launch: note: occupancy query reports %d workgroups per CU\n", per_cu);
        (void)hipGetLastError();
        grid = cus;
    }
    if (grid < 0) return;
    if (hipMemsetAsync((char*)d_ws + WS_CTL, 0, CTL_ZERO_BYTES, stream) != hipSuccess) { fprintf(stderr, "kernel_launch: memset failed\n"); return; }
    Args a{};
    for (int i = 0; i < 24; ++i) a.in[i] = (const float*)d_in[i];
    a.out = (float*)d_out; a.ws = (unsigned char*)d_ws;
    for (int li = 0; li < N_LAUNCHES; ++li) {
        if (N_LAUNCHES == 1) { a.ph_lo = 0; a.ph_hi = PER_PHASE; } else { a.ph_lo = li; a.ph_hi = li + 1; }
        a.li = (N_LAUNCHES == 1) ? 0 : 0;
        hipLaunchKernelGGL(mk_fwd, dim3(grid), dim3(NWAVES * 64), LDS_BYTES, stream, a);
        const hipError_t le = hipPeekAtLastError();
        if (le != hipSuccess) { fprintf(stderr, "kernel_launch: launch %d failed: %s\n", li, hipGetErrorName(le)); break; }
    }
}
```

```cpp
#include <hip/hip_runtime.h>
#include <cstdio>
#include <cstdint>
namespace pg8 {
#define PG8_LAS __attribute__((address_space(3)))
typedef unsigned short bf16_t;
typedef short bf16x8 __attribute__((ext_vector_type(8)));
typedef float f32x4 __attribute__((ext_vector_type(4)));
typedef unsigned u32x4 __attribute__((ext_vector_type(4)));
constexpr int BM = 256, BK = 64, HALF = 128, HTB = HALF * BK * 2  , STAGE_BYTES = 8 * HTB, NXCD = 8, WGM = 8;

__host__ __device__ __forceinline__ int lds_byte(int r, int c) { const int st = (r >> 4) * 2 + (c >> 5), rr = r & 15, cc = c & 31, ob = rr * 64 + cc * 2; return st * 1024 + (ob ^ (((ob >> 9) & 1) << 5)); }
__host__ __device__ __forceinline__ void stage_rc(int b, int& R, int& C) { const int st = b / 1024, sb = b % 1024, swz = sb ^ (((sb >> 9) & 1) << 5); R = (st >> 1) * 16 + swz / 64; C = (st & 1) * 32 + (swz % 64) / 2; }
__host__ __device__ __forceinline__ int perm32(int rho) { const int n = rho >> 4, i = rho & 15; return 8 * (i >> 2) + 4 * n + (i & 3); }

struct Unit { int pm, pn; };
struct Gemm { const bf16_t* A; const bf16_t* Bt; int M, N, K; };

struct StaticOrder {
    int nM, nN, nwg, G, c;
    __host__ __device__ void init(int M, int N, int G_, int c_) { nM = M / BM; nN = N / BM; nwg = nM * nN; G = G_; c = c_; }
    __host__ __device__ bool next(int i, Unit& u) const {
        const long L = (long)i * G + c; if (L >= nwg) return false;
        int wgid = (int)L; { const int q = nwg / NXCD, r = nwg % NXCD, xcd = wgid % NXCD, off = wgid / NXCD; wgid = (xcd < r ? xcd * (q + 1) : r * (q + 1) + (xcd - r) * q) + off; }
        const int nig = WGM * nN, gid = wgid / nig, fm = gid * WGM, gsz = (nM - fm) < WGM ? (nM - fm) : WGM;
        u.pm = fm + ((wgid % nig) % gsz); u.pn = (wgid % nig) / gsz; return true;
    }
    __device__ __forceinline__ void a_ready(const Unit&) const {}
    __device__ __forceinline__ void done(const Unit&) const {}
};

__device__ __forceinline__ unsigned cvt_pk_bf16(float lo, float hi) { unsigned r; asm volatile("v_cvt_pk_bf16_f32 %0, %1, %2" : "=v"(r) : "v"(lo), "v"(hi)); return r; }

template <class Epi, class Sched, bool ALIGN_EPI = false, bool SP2 = false>
__device__ __forceinline__ void gemm_phase(PG8_LAS unsigned char* lds, const Gemm g, const Sched& S, const Epi& E) {
    const int tid = threadIdx.x, wid = __builtin_amdgcn_readfirstlane(tid >> 6), lane = tid & 63, wr = wid >> 2, wc = wid & 3, fr = lane & 15, fq = lane >> 4;
    const int K = g.K, nt = K / BK;
    unsigned voffA[2], voffB[2];
#pragma unroll
    for (int i = 0; i < 2; ++i) { int R, C; stage_rc(tid * 16 + i * 8192, R, C); const int Rb = Epi::PERM ? ((R & ~31) + perm32(R & 31)) : R;
        voffA[i] = (unsigned)(R * K + C) * 2u; voffB[i] = (unsigned)(Rb * K + C) * 2u; }
    const size_t kstep = (size_t)(BK * 2);
    const size_t hstep = (size_t)HALF * K * 2;
    const size_t tstep = 2 * hstep;
    const unsigned ldsw = (unsigned)wid * 1024u;
    const int aoff = lds_byte(wr * 64 + fr, fq * 8), boff = lds_byte(wc * 32 + fr, fq * 8);
#define PG8_SA(b, h) (((b) * 2 + (h)) * HTB)
#define PG8_SB(b, h) ((4 + (b) * 2 + (h)) * HTB)
#define PG8_STAGE(bufoff, gbase, voff) do { _Pragma("unroll") for (int _i = 0; _i < 2; ++_i) \
        __builtin_amdgcn_global_load_lds((const unsigned*)((const char*)(gbase) + (voff)[_i]), (PG8_LAS unsigned*)(lds + (bufoff) + ldsw + _i * 8192), 16, 0, 0); } while (0)
#define PG8_LDA(dst, b, h) do { _Pragma("unroll") for (int m = 0; m < 4; ++m) _Pragma("unroll") for (int k = 0; k < 2; ++k) dst[m][k] = *(const PG8_LAS bf16x8*)(lds + PG8_SA(b, h) + aoff + m * 2048 + k * 1024); } while (0)
#define PG8_LDB(dst, b, h) do { _Pragma("unroll") for (int n = 0; n < 2; ++n) _Pragma("unroll") for (int k = 0; k < 2; ++k) dst[n][k] = *(const PG8_LAS bf16x8*)(lds + PG8_SB(b, h) + boff + n * 2048 + k * 1024); } while (0)
#define PG8_MMA(ai, bj, At, Bt) do { __builtin_amdgcn_s_setprio(1); _Pragma("unroll") for (int m = 0; m < 4; ++m) _Pragma("unroll") for (int n = 0; n < 2; ++n) _Pragma("unroll") for (int k = 0; k < 2; ++k) \
        acc[ai][bj][m][n] = __builtin_amdgcn_mfma_f32_16x16x32_bf16(Bt[n][k], At[m][k], acc[ai][bj][m][n], 0, 0, 0); __builtin_amdgcn_s_setprio(0); } while (0)
#define PG8_WAIT_V(n) asm volatile("s_waitcnt vmcnt(" #n ")" ::: "memory")
#define PG8_WAIT_L(n) asm volatile("s_waitcnt lgkmcnt(" #n ")" ::: "memory")
#define PG8_BAR __builtin_amdgcn_s_barrier()
#define PG8_SCHED __builtin_amdgcn_sched_barrier(0)
    Unit cur, nxt; int ui = 0;
    if (!S.next(0, cur)) return;
    f32x4 acc[2][2][4][2];
#pragma unroll
    for (int a = 0; a < 2; ++a)
#pragma unroll
        for (int b = 0; b < 2; ++b)
#pragma unroll
            for (int m = 0; m < 4; ++m)
#pragma unroll
                for (int n = 0; n < 2; ++n) acc[a][b][m][n] = (f32x4){0.f, 0.f, 0.f, 0.f};
    bf16x8 At[4][2], B0[2][2], B1[2][2];
    const char* cA = (const char*)g.A + (size_t)cur.pm * tstep; const char* cB = (const char*)g.Bt + (size_t)cur.pn * tstep;
    S.a_ready(cur);
    if constexpr (SP2) {
        PG8_STAGE(PG8_SB(0, 0), cB, voffB); PG8_STAGE(PG8_SB(0, 1), cB + hstep, voffB); PG8_STAGE(PG8_SA(0, 0), cA, voffA); PG8_STAGE(PG8_SA(0, 1), cA + hstep, voffA);
        if (wr == 1) PG8_BAR;
        PG8_WAIT_V(2); PG8_BAR;
        PG8_STAGE(PG8_SB(1, 0), cB + kstep, voffB); PG8_STAGE(PG8_SA(1, 0), cA + kstep, voffA); PG8_STAGE(PG8_SB(1, 1), cB + hstep + kstep, voffB);
        PG8_WAIT_V(6); PG8_BAR;
    } else {
        PG8_STAGE(PG8_SB(0, 0), cB, voffB); PG8_STAGE(PG8_SA(0, 0), cA, voffA); PG8_STAGE(PG8_SB(0, 1), cB + hstep, voffB); PG8_STAGE(PG8_SA(0, 1), cA + hstep, voffA);
        if (wr == 1) PG8_BAR;
        PG8_WAIT_V(4); PG8_BAR;
        PG8_STAGE(PG8_SB(1, 0), cB + kstep, voffB); PG8_STAGE(PG8_SA(1, 0), cA + kstep, voffA); PG8_STAGE(PG8_SB(1, 1), cB + hstep + kstep, voffB);
        PG8_WAIT_V(6); PG8_BAR;
    }
    for (;;) {
        const bool has_next = S.next(ui + 1, nxt);
        const char* nA = has_next ? (const char*)g.A + (size_t)nxt.pm * tstep : cA; const char* nB = has_next ? (const char*)g.Bt + (size_t)nxt.pn * tstep : cB;
        for (int t = 0; t < nt; t += 2) {
            const bool last = (t == nt - 2);
            const char* a1 = cA + (size_t)(t + 1) * kstep;
            const char* a2 = last ? nA : cA + (size_t)(t + 2) * kstep; const char* b2 = last ? nB : cB + (size_t)(t + 2) * kstep;
            const char* a3 = a2 + kstep; const char* b3 = b2 + kstep;
            if (last && has_next) S.a_ready(nxt);
            if constexpr (SP2) {
            PG8_LDB(B0, 0, 0); PG8_LDB(B1, 0, 1); PG8_SCHED; PG8_LDA(At, 0, 0); PG8_STAGE(PG8_SA(1, 1), a1 + hstep, voffA);
            PG8_WAIT_V(8); PG8_WAIT_L(0); PG8_BAR; PG8_MMA(0, 0, At, B0); PG8_MMA(0, 1, At, B1); PG8_BAR; PG8_SCHED;
            PG8_LDA(At, 0, 1); PG8_STAGE(PG8_SB(0, 0), b2, voffB); PG8_STAGE(PG8_SB(0, 1), b2 + hstep, voffB); PG8_STAGE(PG8_SA(0, 0), a2, voffA);
            PG8_WAIT_V(8); PG8_WAIT_L(0); PG8_BAR; PG8_MMA(1, 0, At, B0); PG8_MMA(1, 1, At, B1); PG8_BAR; PG8_SCHED;
            PG8_LDB(B0, 1, 0); PG8_LDB(B1, 1, 1); PG8_SCHED; PG8_LDA(At, 1, 0); PG8_STAGE(PG8_SA(0, 1), a2 + hstep, voffA);
            PG8_WAIT_V(8); PG8_WAIT_L(0); PG8_BAR; PG8_MMA(0, 0, At, B0); PG8_MMA(0, 1, At, B1); PG8_BAR; PG8_SCHED;
            PG8_LDA(At, 1, 1); PG8_STAGE(PG8_SB(1, 0), b3, voffB); PG8_STAGE(PG8_SB(1, 1), b3 + hstep, voffB); PG8_STAGE(PG8_SA(1, 0), a3, voffA);
            PG8_WAIT_V(8); PG8_WAIT_L(0); PG8_BAR; PG8_MMA(1, 0, At, B0); PG8_MMA(1, 1, At, B1); PG8_BAR; PG8_SCHED;
            } else {
            PG8_LDB(B0, 0, 0); PG8_SCHED; PG8_LDA(At, 0, 0); PG8_STAGE(PG8_SA(1, 1), a1 + hstep, voffA);
            PG8_WAIT_L(8); PG8_BAR; PG8_WAIT_L(0); PG8_MMA(0, 0, At, B0); PG8_BAR; PG8_SCHED;
            PG8_LDB(B1, 0, 1); PG8_STAGE(PG8_SB(0, 0), b2, voffB);
            PG8_BAR; PG8_WAIT_L(0); PG8_MMA(0, 1, At, B1); PG8_BAR;
            PG8_LDA(At, 0, 1); PG8_STAGE(PG8_SA(0, 0), a2, voffA);
            PG8_BAR; PG8_WAIT_L(0); PG8_MMA(1, 0, At, B0); PG8_BAR; PG8_SCHED;
            PG8_STAGE(PG8_SB(0, 1), b2 + hstep, voffB);
            PG8_WAIT_V(6); PG8_BAR; PG8_MMA(1, 1, At, B1); PG8_BAR;
            PG8_LDB(B0, 1, 0); PG8_SCHED; PG8_LDA(At, 1, 0); PG8_STAGE(PG8_SA(0, 1), a2 + hstep, voffA);
            PG8_WAIT_L(8); PG8_BAR; PG8_WAIT_L(0); PG8_MMA(0, 0, At, B0); PG8_BAR; PG8_SCHED;
            PG8_LDB(B1, 1, 1); PG8_STAGE(PG8_SB(1, 0), b3, voffB);
            PG8_BAR; PG8_WAIT_L(0); PG8_MMA(0, 1, At, B1); PG8_BAR;
            PG8_LDA(At, 1, 1); PG8_STAGE(PG8_SA(1, 0), a3, voffA);
            PG8_BAR; PG8_WAIT_L(0); PG8_MMA(1, 0, At, B0); PG8_BAR; PG8_SCHED;
            PG8_STAGE(PG8_SB(1, 1), b3 + hstep, voffB);
            PG8_WAIT_V(6); PG8_BAR; PG8_MMA(1, 1, At, B1); PG8_BAR;
            }
        }
        if constexpr (ALIGN_EPI) { if (wr == 0) PG8_BAR; }
        if constexpr (!Epi::AFTER_DRAIN) { E(acc, cur, wr, wc, fr, fq);
            S.done(cur); }
        if (!has_next) break;
#pragma unroll
        for (int a = 0; a < 2; ++a)
#pragma unroll
            for (int b = 0; b < 2; ++b)
#pragma unroll
                for (int m = 0; m < 4; ++m)
#pragma unroll
                    for (int n = 0; n < 2; ++n) acc[a][b][m][n] = (f32x4){0.f, 0.f, 0.f, 0.f};
        cur = nxt; cA = nA; cB = nB; ++ui;
        if constexpr (ALIGN_EPI) { if (wr == 1) PG8_BAR; }
    }
    PG8_WAIT_V(0);
    if constexpr (!ALIGN_EPI) { if (wr == 0) PG8_BAR; }
    PG8_BAR;
    if constexpr (Epi::AFTER_DRAIN) { E.fused(acc, cur, wr, wc, fr, fq, lds, wid, lane); S.done(cur); }
#undef PG8_SA
#undef PG8_SB
#undef PG8_STAGE
#undef PG8_LDA
#undef PG8_LDB
#undef PG8_MMA
#undef PG8_WAIT_V
#undef PG8_WAIT_L
#undef PG8_BAR
#undef PG8_SCHED
}
}

constexpr int DM = 1024, NB = 8, T = 2048, ST = 16, PAST = 4096;
constexpr int MP = NB * T;
constexpr int MS = NB * ST;
constexpr int MTOK = MP + MS;
constexpr int MPAD = 16640;
constexpr int NIN = 4096;
constexpr int NMEMTOK = NB * 256;
constexpr int WIN = 3888;
constexpr float EPS = 1e-6f;
constexpr float IDX_SCALE = 0.0625f;
constexpr int NWAVES = 8;
#ifndef MK_N_LAUNCHES
#define MK_N_LAUNCHES 1
#endif
constexpr int N_LAUNCHES = MK_N_LAUNCHES;
constexpr int PER_PHASE = 6;

constexpr size_t OFF_YP = 0, OFF_YS = 16777216, OFF_PCONV = 16908288, OFF_PSSM = 16945152, OFF_PK = 17469440, OFF_PV = 21663744,
                 OFF_PKI = 25858048, OFF_PMK = 26382336, OFF_PMV = 26906624, OFF_SCONV = 27430912, OFF_SSSM = 27467776,
                 OFF_SK = 27992064, OFF_SV = 28024832, OFF_SKI = 28057600, OUT_TOTAL = 28061696;

constexpr size_t MiB = 1u << 20;
constexpr size_t WS_CTL = 0, CTL_ZERO_BYTES = 96 * 1024;
constexpr size_t WS_WOUT = 1 * MiB;
constexpr size_t WS_WIN = 3 * MiB;
constexpr size_t WS_XN = 12 * MiB;
constexpr int MALL = MPAD + 2048, NALL = NIN + 512;
constexpr size_t WS_MIX = WS_XN;
constexpr size_t WS_QKVA = 49 * MiB;
constexpr size_t WS_OA = WS_QKVA;
constexpr size_t WS_ZA = 98 * MiB;
constexpr size_t ROWBUF = (size_t)MPAD * 256 * 2;
constexpr size_t WS_QB = 115 * MiB;
constexpr size_t WS_KB = WS_QB + ROWBUF, WS_VB = WS_KB + ROWBUF, WS_ZB = WS_VB + ROWBUF, WS_QI = WS_ZB + ROWBUF, WS_QM = WS_QI + ROWBUF, WS_ZM = WS_QM + ROWBUF;
constexpr size_t WS_SMALL = 172 * MiB;
constexpr size_t WS_KI = WS_SMALL + (size_t)MPAD * 64 + 65536;
constexpr size_t WS_MEMK = 175 * MiB, WS_MEMV = 176 * MiB;
constexpr int NGITEM = 1056;
constexpr size_t WS_GWK = 177 * MiB;
constexpr size_t GBIG = (size_t)NGITEM * 64 * 128 * 2;
constexpr size_t WS_GQD = WS_GWK + GBIG, WS_GKDT = WS_GQD + GBIG, WS_GU0 = WS_GKDT + GBIG, WS_GQK = WS_GU0 + GBIG;
constexpr size_t WS_GLAST = WS_GQK + GBIG / 2;
constexpr size_t WS_SLIST = 251 * MiB + 512 * 1024;
constexpr size_t WS_SELW = 252 * MiB;
constexpr size_t WS_END = WS_SELW + (size_t)MP * 256;
static_assert(WS_GLAST + 8192 <= WS_SLIST && WS_SLIST + 128 * 256 * 4 <= WS_SELW, "ws map 2");
static_assert(WS_ZM + ROWBUF <= WS_SMALL && WS_KI + (size_t)MPAD * 64 <= WS_MEMK && WS_XN + (size_t)MALL * 2048 <= WS_QKVA && WS_WIN + (size_t)NALL * 2048 <= WS_XN && WS_QKVA + (size_t)MPAD * 3072 <= WS_ZA && WS_ZA + (size_t)MPAD * 1024 <= WS_QB && WS_END <= 256 * MiB, "ws map");

constexpr int CW_TMO = 0, CW_CODE = 1;
constexpr int CW_Q0 = 64, CW_Q1 = 128, CW_Q2 = 192;
constexpr int CW_BAR = 4096;
constexpr int CW_GATE = 16384;

constexpr int LDS_BYTES = 163840;
constexpr int LDS_MAIN = 0;
constexpr int LDS_X = 131072;
constexpr int LDSCTL_OFF = 163840 - 512;
constexpr int MISC_OFF = LDSCTL_OFF;

#define GAS __attribute__((address_space(1)))
#define LAS __attribute__((address_space(3)))
typedef unsigned short bf16;
typedef unsigned v4u __attribute__((ext_vector_type(4)));
typedef unsigned v2u __attribute__((ext_vector_type(2)));
typedef float f32x4 __attribute__((ext_vector_type(4)));
typedef short bf16x8 __attribute__((ext_vector_type(8)));
typedef short s16x4 __attribute__((ext_vector_type(4)));
typedef GAS unsigned gu32;
#define RLX_AGENT __ATOMIC_RELAXED, __HIP_MEMORY_SCOPE_AGENT
#define LDS_WAIT() asm volatile("s_waitcnt lgkmcnt(0)" ::: "memory")
#define VM_WAIT() asm volatile("s_waitcnt vmcnt(0)" ::: "memory")
__device__ __forceinline__ unsigned f2bf(float f) { unsigned u = __builtin_bit_cast(unsigned, f); return (u + 0x7fffu + ((u >> 16) & 1u)) >> 16; }
typedef float f32x2_t __attribute__((ext_vector_type(2))); typedef __bf16 bf16x2_t __attribute__((ext_vector_type(2)));
__device__ __forceinline__ unsigned pk2(float lo, float hi) { const f32x2_t v = {lo, hi}; const bf16x2_t b = __builtin_convertvector(v, bf16x2_t); return __builtin_bit_cast(unsigned, b); }
__device__ __forceinline__ float bf2f(unsigned short b) { return __builtin_bit_cast(float, ((unsigned)b) << 16); }
__device__ __forceinline__ float bflo(unsigned w) { return __builtin_bit_cast(float, w << 16); }
__device__ __forceinline__ float bfhi(unsigned w) { return __builtin_bit_cast(float, w & 0xffff0000u); }
__device__ __forceinline__ float fexp2(float x) { return __builtin_amdgcn_exp2f(x); }
__device__ __forceinline__ float frcp(float x) { return __builtin_amdgcn_rcpf(x); }
__device__ __forceinline__ float silu_f(float x) { return x * frcp(1.0f + fexp2(-1.4426950408889634f * x)); }
__device__ __forceinline__ float wave_sum(float v) {
#pragma unroll
    for (int o = 1; o < 64; o <<= 1) v += __shfl_xor(v, o);
    return v;
}

#define XB_TMO      128
#define XB_XCNT(j)  (256  + 64 * (j))
#define XB_XSUB(j)  (1280 + 64 * (j))
#define XB_XGEN(j)  (2304 + 64 * (j))
#define XB_TOP      3328
#define XB_TOPGEN   3392
#define XCD_BAR_WORDS 3456
#define XB_SPIN_CAP (1u << 20)
__device__ __forceinline__ unsigned xb_ld(unsigned* p)              { return __hip_atomic_load(p, __ATOMIC_RELAXED, __HIP_MEMORY_SCOPE_AGENT); }
__device__ __forceinline__ unsigned xb_add(unsigned* p, unsigned v) { return __hip_atomic_fetch_add(p, v, __ATOMIC_RELAXED, __HIP_MEMORY_SCOPE_AGENT); }
__device__ __forceinline__ unsigned xb_xcc_id() { return (unsigned)__builtin_amdgcn_s_getreg((3 << 11) | 20) & 0xFu; }
#define XB_SPIN(cond, bar) do { unsigned _sp = 0; while (cond) { __builtin_amdgcn_s_sleep(1); \
    if ((++_sp & 255u) == 0u) { if (xb_ld(&(bar)[XB_TMO])) break; if (_sp > XB_SPIN_CAP) { atomicAdd(&(bar)[XB_TMO], 1u); break; } } } } while (0)
struct XcdBarrier { unsigned* bar; unsigned x; volatile LAS unsigned* st; };
__device__ __forceinline__ XcdBarrier xcd_barrier_post(unsigned* bar, volatile LAS unsigned* st) {
    XcdBarrier b; b.bar = bar; b.x = xb_xcc_id(); b.st = st;
    if (threadIdx.x == 0) (void)xb_add(&bar[XB_XCNT(b.x)], 1u);
    return b;
}
__device__ __forceinline__ void xcd_barrier_complete(unsigned* bar, unsigned x, unsigned& nloc, unsigned& nx) {
    const unsigned G = gridDim.x * gridDim.y * gridDim.z;
    unsigned sum, cnt, mine, sp = 0u;
    for (;;) {
        sum = 0u; cnt = 0u; mine = 0u;
#pragma unroll
        for (unsigned j = 0; j < 16; ++j) { const unsigned c = xb_ld(&bar[XB_XCNT(j)]); sum += c; cnt += (c > 0u) ? 1u : 0u; mine = (j == x) ? c : mine; }
        if (sum == G) break;
        __builtin_amdgcn_s_sleep(1);
        if ((++sp & 255u) == 0u) { if (xb_ld(&bar[XB_TMO])) break; if (sp > XB_SPIN_CAP) { atomicAdd(&bar[XB_TMO], 1u); break; } }
    }
    nloc = mine > 0u ? mine : 1u; nx = cnt > 0u ? cnt : 1u;
}
__device__ __forceinline__ void xcd_barrier(const XcdBarrier& b) {
    asm volatile("s_waitcnt vmcnt(0)" ::: "memory");
    __syncthreads();
    if (threadIdx.x == 0) {
        unsigned* bar = b.bar;
        __builtin_amdgcn_s_waitcnt(0);
        unsigned nloc = b.st[0], nx = b.st[1];
        if (nloc == 0u) { xcd_barrier_complete(bar, b.x, nloc, nx); b.st[0] = nloc; b.st[1] = nx; }
        const unsigned old = xb_add(&bar[XB_XSUB(b.x)], 1u);
        const unsigned gen = old / nloc;
        if (old + 1u == (gen + 1u) * nloc) {
            __builtin_amdgcn_fence(__ATOMIC_RELEASE, "agent");
            asm volatile("s_waitcnt vmcnt(0)" ::: "memory");
            const unsigned og = xb_add(&bar[XB_TOP], 1u);
            const unsigned tg = og / nx;
            if (og + 1u == (tg + 1u) * nx) xb_add(&bar[XB_TOPGEN], 1u);
            else XB_SPIN(xb_ld(&bar[XB_TOPGEN]) == tg, bar);
            __builtin_amdgcn_fence(__ATOMIC_ACQUIRE, "agent");
            xb_add(&bar[XB_XGEN(b.x)], 1u);
            asm volatile("s_waitcnt vmcnt(0)" ::: "memory");
        } else {
            XB_SPIN(xb_ld(&bar[XB_XGEN(b.x)]) == gen, bar);
            __builtin_amdgcn_fence(__ATOMIC_ACQUIRE, "agent");
            asm volatile("s_waitcnt vmcnt(0)" ::: "memory");
        }
    }
    __syncthreads();
}

struct Frame {
    LAS unsigned char* lds;
    volatile LAS unsigned* MISC;
    gu32* ctl;
    int tid, lane, wave, vcu, G;
    float* out;
    unsigned char* ws;
};
struct Args { const float* in[24]; float* out; unsigned char* ws; int ph_lo, ph_hi, li, pad; };
constexpr size_t WS_PAR = 512 * 1024;
constexpr int PAR_GQB = 0, PAR_GKB = 64, PAR_GKI = 128, PAR_GQM = 192, PAR_ALOG = 256, PAR_DTB = 260, PAR_GKM = 320, PAR_GO = 384, PAR_BNDB = 512, PAR_BNDC = 513, PAR_GQMX = 514, PAR_END = 520;

__device__ __forceinline__ int hperm(int tc) { return 64 * ((tc >> 5) & 3) + 32 * (tc >> 7) + (tc & 31); }
__device__ __forceinline__ int win_src_col(int np) {
    const int tile = np >> 8, tc = np & 255;
    if (tile < 8) return np;
    switch (tile) {
        case 8: return 2056 + hperm(tc);
        case 9: return 2312 + hperm(tc);
        case 10: return 2568 + tc;
        case 11: return 2824 + tc;
        case 12: return 3080 + tc;
        case 13: return 3376 + hperm(tc);
        case 14: return 3632 + tc;
        default:
            if (tc < 32) return 3336 + tc;
            if (tc < 36) return 2048 + tc - 32;
            if (tc < 40) return 2052 + tc - 36;
            if (tc < 48) return 3368 + tc - 40;
            return -1;
    }
}
__device__ __forceinline__ void p0_transpose_item(const float* W, int ldw, int K, bf16* WT, int n0, int k0, int srcc, LAS float* scr, int lane) {
#pragma unroll 8
    for (int i = 0; i < 32; ++i) { const int kk = 2 * i + (lane >> 5); scr[kk * 33 + (lane & 31)] = srcc >= 0 ? W[(size_t)(k0 + kk) * ldw + srcc] : 0.f; }
    LDS_WAIT(); asm volatile("" ::: "memory");
    const int c = lane & 7;
#pragma unroll
    for (int j = 0; j < 4; ++j) { const int n = (lane >> 3) + 8 * j; const LAS float* s = scr + (8 * c) * 33 + n;
        v4u o; o.x = pk2(s[0 * 33], s[1 * 33]); o.y = pk2(s[2 * 33], s[3 * 33]); o.z = pk2(s[4 * 33], s[5 * 33]); o.w = pk2(s[6 * 33], s[7 * 33]);
        *(GAS v4u*)(WT + (size_t)(n0 + n) * K + k0 + 8 * c) = o; }
    LDS_WAIT(); asm volatile("" ::: "memory");
}
__device__ __forceinline__ void rms_row_to_bf16(const float* xrow, const float* g, bf16* orow, int lane) {
    const GAS f32x4* xr = (const GAS f32x4*)xrow + lane; const GAS f32x4* gr = (const GAS f32x4*)g + lane;
    f32x4 v[4]; float s = 0.f;
#pragma unroll
    for (int j = 0; j < 4; ++j) { v[j] = xr[64 * j]; s += (v[j].x * v[j].x + v[j].y * v[j].y) + (v[j].z * v[j].z + v[j].w * v[j].w); }
    const float rs = 1.0f / sqrtf(wave_sum(s) * (1.f / 1024.f) + EPS);
    GAS v2u* o8 = (GAS v2u*)orow + lane;
#pragma unroll
    for (int j = 0; j < 4; ++j) { const f32x4 gg = gr[64 * j]; v2u w; w.x = pk2(v[j].x * rs * gg.x, v[j].y * rs * gg.y); w.y = pk2(v[j].z * rs * gg.z, v[j].w * rs * gg.w); o8[64 * j] = w; }
}
__device__ __forceinline__ void p0_prologue(Frame& F, const Args& A) {
    LAS float* scr = (LAS float*)(F.lds + LDS_MAIN + F.wave * 16384);
    const int gw = F.vcu * NWAVES + F.wave, NGW = F.G * NWAVES;
    if (blockIdx.x == 0) {
        float* par = (float*)(F.ws + WS_PAR); const int t = F.tid;
        if (t < 64) { par[PAR_GQB + t] = A.in[16][t]; par[PAR_GKB + t] = A.in[17][t]; par[PAR_GQM + t] = A.in[21][t]; par[PAR_GKM + t] = A.in[22][t]; }
        if (t < 32) par[PAR_GKI + t] = A.in[18][t];
        if (t < 4) { par[PAR_ALOG + t] = A.in[13][t]; par[PAR_DTB + t] = A.in[14][t]; }
        if (t < 128) par[PAR_GO + t] = A.in[15][t];
        if (t < 64) {
            float a = fabsf(A.in[16][t]), b = fabsf(A.in[17][t]), c2 = fabsf(A.in[21][t]), d = fabsf(A.in[22][t]);
#pragma unroll
            for (int o = 1; o < 64; o <<= 1) { a = fmaxf(a, __shfl_xor(a, o)); b = fmaxf(b, __shfl_xor(b, o)); c2 = fmaxf(c2, __shfl_xor(c2, o)); d = fmaxf(d, __shfl_xor(d, o)); }
            if (t == 0) { par[PAR_BNDB] = 8.0f * a * b * 1.4426950408889634f; par[PAR_BNDC] = 8.0f * c2 * d * 1.4426950408889634f; par[PAR_GQMX] = c2; }
        }
    }
    constexpr int I_IN = 16 * 128, I_OUT = 16 * 32, I_MEM = 16 * 16;
    bf16* WinT = (bf16*)(F.ws + WS_WIN); bf16* WoutT = (bf16*)(F.ws + WS_WOUT); bf16* WmemT = WinT + (size_t)NIN * DM;
    const int gw2 = F.vcu + F.G * F.wave;
    for (int it = gw, pass = 0; it < I_IN + I_OUT + I_MEM; ++pass, it = pass * NGW + gw2) {
        int r = it;
        if (r < I_IN) { const int kb = r / 128, nb = r % 128; p0_transpose_item(A.in[11], WIN, 1024, WinT, 32 * nb, 64 * kb, win_src_col(32 * nb + (F.lane & 31)), scr, F.lane); continue; }
        r -= I_IN;
        if (r < I_OUT) { const int kb = r / 32, nb = r % 32; p0_transpose_item(A.in[23], 1024, 1024, WoutT, 32 * nb, 64 * kb, 32 * nb + (F.lane & 31), scr, F.lane); continue; }
        r -= I_OUT;
        { const int kb = r / 16, nb = r % 16; const int np = 32 * nb + (F.lane & 31); p0_transpose_item(A.in[20], 512, 1024, WmemT, 32 * nb, 64 * kb, np < 256 ? hperm(np) : np, scr, F.lane); }
    }
    bf16* XN = (bf16*)(F.ws + WS_XN);
    f32x4 gA[4], gM[4];
#pragma unroll
    for (int j = 0; j < 4; ++j) { gA[j] = *((const GAS f32x4*)A.in[10] + F.lane + 64 * j); gM[j] = *((const GAS f32x4*)A.in[19] + F.lane + 64 * j); }
#pragma unroll 1
    for (int m0 = gw; m0 < MALL; m0 += 5 * NGW) {
        f32x4 v[5][4]; bool live[5], zero[5], memg[5];
#pragma unroll
        for (int i = 0; i < 5; ++i) {
            const int m = m0 + i * NGW; live[i] = m < MALL; const int mm = live[i] ? m : 0;
            zero[i] = mm >= MTOK && mm < MPAD;
            const float* src = mm < MP ? A.in[0] + (size_t)mm * DM : (mm < MTOK ? A.in[1] + (size_t)(mm - MP) * DM : (mm < MPAD ? A.in[0] : A.in[9] + (size_t)(mm - MPAD) * DM));
            memg[i] = mm >= MPAD;
#pragma unroll
            for (int j = 0; j < 4; ++j) v[i][j] = *((const GAS f32x4*)src + F.lane + 64 * j);
        }
#pragma unroll
        for (int i = 0; i < 5; ++i) {
            float s = 0.f;
#pragma unroll
            for (int j = 0; j < 4; ++j) s += (v[i][j].x * v[i][j].x + v[i][j].y * v[i][j].y) + (v[i][j].z * v[i][j].z + v[i][j].w * v[i][j].w);
            const float rs = zero[i] ? 0.f : 1.0f / sqrtf(wave_sum(s) * (1.f / 1024.f) + EPS);
            if (live[i]) {
                GAS v2u* o8 = (GAS v2u*)(XN + (size_t)(m0 + i * NGW) * DM) + F.lane;
#pragma unroll
                for (int j = 0; j < 4; ++j) { const f32x4 gg = memg[i] ? gM[j] : gA[j];
                    v2u w; w.x = pk2(v[i][j].x * rs * gg.x, v[i][j].y * rs * gg.y); w.y = pk2(v[i][j].z * rs * gg.z, v[i][j].w * rs * gg.w); o8[64 * j] = w; }
            }
        }
    }
}

__device__ __forceinline__ v4u pack8(const f32x4 a, const f32x4 b) { v4u w; w.x = pk2(a[0], a[1]); w.y = pk2(a[2], a[3]); w.z = pk2(b[0], b[1]); w.w = pk2(b[2], b[3]); return w; }
struct InOrder {
    pg8::StaticOrder so;
    __device__ void init(int G_, int c_) { so.init(MPAD, 15 * 256, G_, c_); }
    __device__ bool next(int i, pg8::Unit& u) const { return so.next(i, u); }
    __device__ __forceinline__ void a_ready(const pg8::Unit&) const {}
    __device__ __forceinline__ void done(const pg8::Unit&) const {}
};
struct MemOrder {
    int bx;
    __device__ bool next(int i, pg8::Unit& u) const { if (i != 0) return false; u.pm = 65 + (bx >> 1); u.pn = 16 + (bx & 1); return true; }
    __device__ __forceinline__ void a_ready(const pg8::Unit&) const {}
    __device__ __forceinline__ void done(const pg8::Unit&) const {}
};
struct EpiIn {
    static constexpr bool PERM = true, AFTER_DRAIN = false;
    unsigned char* ws; float* out;
    __device__ __forceinline__ void operator()(const pg8::f32x4 (&acc)[2][2][4][2], const pg8::Unit& u, int wr, int wc, int fr, int fq) const {
        const int pn = u.pn, tcb = wc * 32 + 8 * fq;
        const bool hp = (pn == 8 || pn == 9 || pn == 13 || pn == 16);
        const bool gate = (pn == 6 || pn == 7 || pn == 11 || pn == 14);
        size_t b16 = 0; int ld16 = 256, c16 = hp ? wc * 64 + 8 * fq : tcb, bjs = hp ? 32 : 128; int gpar = 0;
        switch (pn) {
            case 0: case 1: case 2: case 3: case 4: case 5: b16 = WS_QKVA; ld16 = 1536; c16 += pn * 256; break;
            case 6: case 7: b16 = WS_ZA; ld16 = 512; c16 += (pn - 6) * 256; break;
            case 8: b16 = WS_QB; gpar = PAR_GQB; break;
            case 9: b16 = WS_KB; gpar = PAR_GKB; break;
            case 10: b16 = WS_VB; break;
            case 11: b16 = WS_ZB; break;
            case 12: b16 = WS_QI; break;
            case 13: b16 = WS_QM; gpar = PAR_GQM; break;
            case 14: b16 = WS_ZM; break;
            case 16: b16 = WS_MEMK; gpar = PAR_GKM; break;
            case 17: b16 = WS_MEMV; break;
            default: break;
        }
        const float* par = (const float*)(ws + WS_PAR);
#pragma unroll
        for (int ai = 0; ai < 2; ++ai)
#pragma unroll
        for (int m = 0; m < 4; ++m) {
            int row = u.pm * 256 + ai * 128 + wr * 64 + m * 16 + fr;
            const bool memrow = pn >= 16;
            if (memrow) row -= MPAD;
            const bool valid = memrow || row < MTOK;
            const bool prompt = row < MP;
            if (pn != 15) {
                f32x4 v[2][2];
#pragma unroll
                for (int bj = 0; bj < 2; ++bj) { v[bj][0] = acc[ai][bj][m][0]; v[bj][1] = acc[ai][bj][m][1]; }
                if (gate) {
#pragma unroll
                    for (int bj = 0; bj < 2; ++bj)
#pragma unroll
                        for (int n = 0; n < 2; ++n)
#pragma unroll
                            for (int j = 0; j < 4; ++j) v[bj][n][j] = silu_f(v[bj][n][j]);
                }
                if (hp) {
                    float ss = 0.f;
#pragma unroll
                    for (int bj = 0; bj < 2; ++bj)
#pragma unroll
                        for (int n = 0; n < 2; ++n) { const f32x4 x = v[bj][n]; ss += (x[0] * x[0] + x[1] * x[1]) + (x[2] * x[2] + x[3] * x[3]); }
                    ss += __shfl_xor(ss, 16); ss += __shfl_xor(ss, 32);
                    const float rs = 1.0f / sqrtf(ss * (1.f / 64.f) + EPS);
#pragma unroll
                    for (int bj = 0; bj < 2; ++bj)
#pragma unroll
                        for (int n = 0; n < 2; ++n) v[bj][n] = v[bj][n] * rs * *(const GAS f32x4*)(par + gpar + 32 * bj + 8 * fq + 4 * n);
                }
                if (valid) {
                    bf16* dst = (bf16*)(ws + b16) + (size_t)row * ld16 + c16;
                    float* o = nullptr;
                    if (pn == 9) o = out + (prompt ? OFF_PK + (size_t)row * 256 : OFF_SK + (size_t)(row - MP) * 256) + c16;
                    else if (pn == 10) o = out + (prompt ? OFF_PV + (size_t)row * 256 : OFF_SV + (size_t)(row - MP) * 256) + c16;
                    else if (pn == 16) o = out + OFF_PMK + (size_t)row * 256 + c16;
                    else if (pn == 17) o = out + OFF_PMV + (size_t)row * 256 + c16;
                    else if (pn < 6) {
                        if (prompt) { const int t = row & 2047; if (t >= 2045) o = out + OFF_PCONV + (size_t)((row >> 11) * 3 + (t - 2045)) * 1536 + c16; }
                        else { const int rr = row - MP, t = rr & 15; if (t >= 13) o = out + OFF_SCONV + (size_t)((rr >> 4) * 3 + (t - 13)) * 1536 + c16; }
                    }
#pragma unroll
                    for (int bj = 0; bj < 2; ++bj) {
                        *(GAS v4u*)(dst + bj * bjs) = pack8(v[bj][0], v[bj][1]);
                        if (o) { *(GAS f32x4*)(o + bj * bjs) = v[bj][0]; *(GAS f32x4*)(o + bj * bjs + 4) = v[bj][1]; }
                    }
                }
            } else {
                const f32x4 x0 = acc[ai][0][m][0], x1 = acc[ai][0][m][1];
                if (wc == 0) {
                    float ss = (x0[0] * x0[0] + x0[1] * x0[1]) + (x0[2] * x0[2] + x0[3] * x0[3]) + (x1[0] * x1[0] + x1[1] * x1[1]) + (x1[2] * x1[2] + x1[3] * x1[3]);
                    ss += __shfl_xor(ss, 16); ss += __shfl_xor(ss, 32);
                    const float rs = 1.0f / sqrtf(ss * (1.f / 32.f) + EPS);
                    if (valid) {
                        const f32x4 a = x0 * rs * *(const GAS f32x4*)(par + PAR_GKI + 8 * fq), b = x1 * rs * *(const GAS f32x4*)(par + PAR_GKI + 8 * fq + 4);
                        float* o = out + (prompt ? OFF_PKI + (size_t)row * 32 : OFF_SKI + (size_t)(row - MP) * 32) + 8 * fq;
                        *(GAS f32x4*)o = a; *(GAS f32x4*)(o + 4) = b;
                        *(GAS v4u*)((bf16*)(ws + WS_KI) + (size_t)row * 32 + 8 * fq) = pack8(a, b);
                    }
                } else if (wc == 1 && valid && fq < 2) {
                    float* sm = (float*)(ws + WS_SMALL) + (size_t)row * 16 + 8 * fq;
                    const float sc = fq == 0 ? 1.0f : IDX_SCALE;
                    *(GAS f32x4*)sm = x0 * sc; *(GAS f32x4*)(sm + 4) = x1 * sc;
                }
            }
        }
    }
};
struct EpiOut {
    static constexpr bool PERM = true, AFTER_DRAIN = false;
    const float* xp; const float* xs; float* out;
    __device__ __forceinline__ void operator()(const pg8::f32x4 (&acc)[2][2][4][2], const pg8::Unit& u, int wr, int wc, int fr, int fq) const {
        const int col0 = u.pn * 256 + wc * 32 + 8 * fq;
#pragma unroll
        for (int ai = 0; ai < 2; ++ai)
#pragma unroll
        for (int m = 0; m < 4; ++m) {
            const int row = u.pm * 256 + ai * 128 + wr * 64 + m * 16 + fr;
            if (row < MTOK) {
                const float* xr = (row < MP ? xp + (size_t)row * DM : xs + (size_t)(row - MP) * DM) + col0;
                float* o = out + (size_t)row * DM + col0;
#pragma unroll
                for (int bj = 0; bj < 2; ++bj) {
                    const f32x4 x0 = *(const GAS f32x4*)(xr + bj * 128), x1 = *(const GAS f32x4*)(xr + bj * 128 + 4);
                    *(GAS f32x4*)(o + bj * 128) = x0 + acc[ai][bj][m][0]; *(GAS f32x4*)(o + bj * 128 + 4) = x1 + acc[ai][bj][m][1];
                }
            }
        }
    }
};

constexpr int SW_RS = 2064;
__device__ __forceinline__ void small_stage_w(unsigned char* ws, LAS unsigned char* L, int tid) {
    const bf16* WT = (const bf16*)(ws + WS_WIN) + (size_t)3840 * DM;
#pragma unroll
    for (int i = 0; i < 12; ++i) { const int q = tid + 512 * i, row = q >> 7, c16 = q & 127; *(LAS v4u*)(L + row * SW_RS + 16 * c16) = *(const GAS v4u*)(WT + (size_t)row * DM + 8 * c16); }
}
__device__ __forceinline__ void small_item(unsigned char* ws, float* out, const LAS unsigned char* L, int r0, int tid_) {
    int tid = tid_; asm volatile("" : "+v"(tid));
    const int lane = tid & 63, wave = __builtin_amdgcn_readfirstlane(tid >> 6), g = lane >> 4, c = lane & 15;
    const bf16* XN = (const bf16*)(ws + WS_XN) + (size_t)(r0 + 16 * wave + c) * DM + 8 * g;
    const LAS unsigned char* WL = L + c * SW_RS + 16 * g;
    f32x4 acc[3] = {{0.f, 0.f, 0.f, 0.f}, {0.f, 0.f, 0.f, 0.f}, {0.f, 0.f, 0.f, 0.f}};
    bf16x8 a[32];
#pragma unroll
    for (int i = 0; i < 32; ++i) a[i] = *(const GAS bf16x8*)(XN + 32 * i);
#pragma unroll
    for (int i = 0; i < 32; ++i)
#pragma unroll
        for (int t = 0; t < 3; ++t) acc[t] = __builtin_amdgcn_mfma_f32_16x16x32_bf16(a[i], *(const LAS bf16x8*)(WL + 16 * t * SW_RS + 64 * i), acc[t], 0, 0, 0);
    const float* par = (const float*)(ws + WS_PAR);
    const float gk0 = par[PAR_GKI + c], gk1 = par[PAR_GKI + 16 + c];
#pragma unroll
    for (int r = 0; r < 4; ++r) {
        const int row = r0 + 16 * wave + 4 * g + r;
        float ss = acc[0][r] * acc[0][r] + acc[1][r] * acc[1][r];
        ss += __shfl_xor(ss, 1); ss += __shfl_xor(ss, 2); ss += __shfl_xor(ss, 4); ss += __shfl_xor(ss, 8);
        const float rs = 1.0f / sqrtf(ss * (1.f / 32.f) + EPS);
        if (row < MTOK) {
            const float k0 = acc[0][r] * rs * gk0, k1 = acc[1][r] * rs * gk1;
            float* o = out + (row < MP ? OFF_PKI + (size_t)row * 32 : OFF_SKI + (size_t)(row - MP) * 32);
            o[c] = k0; o[16 + c] = k1;
            bf16* kd = (bf16*)(ws + WS_KI) + (size_t)row * 32;
            kd[c] = (bf16)f2bf(k0); kd[16 + c] = (bf16)f2bf(k1);
            ((float*)(ws + WS_SMALL))[(size_t)row * 16 + c] = c < 8 ? acc[2][r] : acc[2][r] * IDX_SCALE;
        }
    }
}
__device__ __forceinline__ void sample_out_item(unsigned char* ws, const float* xs, float* out, int bx, int tid_) {
    int tid = tid_; asm volatile("" : "+v"(tid));
    const int lane = tid & 63, wave = __builtin_amdgcn_readfirstlane(tid >> 6), g = lane >> 4, c = lane & 15;
    const bf16* MX = (const bf16*)(ws + WS_MIX) + (size_t)(MP + 16 * wave + c) * DM + 8 * g;
    const bf16* WT = (const bf16*)(ws + WS_WOUT) + (size_t)(16 * bx + c) * DM + 8 * g;
    f32x4 acc = {0.f, 0.f, 0.f, 0.f};
#pragma unroll 1
    for (int k0 = 0; k0 < 32; k0 += 16) {
        bf16x8 a[16], w[16];
#pragma unroll
        for (int i = 0; i < 16; ++i) { a[i] = *(const GAS bf16x8*)(MX + 32 * (k0 + i)); w[i] = *(const GAS bf16x8*)(WT + 32 * (k0 + i)); }
        __builtin_amdgcn_sched_barrier(0);
#pragma unroll
        for (int i = 0; i < 16; ++i) acc = __builtin_amdgcn_mfma_f32_16x16x32_bf16(a[i], w[i], acc, 0, 0, 0);
    }
#pragma unroll
    for (int r = 0; r < 4; ++r) { const int row = 16 * wave + 4 * g + r; out[OFF_YS + (size_t)row * DM + 16 * bx + c] = xs[(size_t)row * DM + 16 * bx + c] + acc[r]; }
}

#define MFMA16(a, b, c) __builtin_amdgcn_mfma_f32_16x16x32_bf16((a), (b), (c), 0, 0, 0)
typedef short v4i16_t __attribute__((ext_vector_type(4)));
__device__ __forceinline__ bf16x8 lds_frag16(const LAS unsigned char* p) { return *(const LAS bf16x8*)p; }
__device__ __forceinline__ bf16x8 cat44(s16x4 lo, s16x4 hi) { bf16x8 r; r[0] = lo[0]; r[1] = lo[1]; r[2] = lo[2]; r[3] = lo[3]; r[4] = hi[0]; r[5] = hi[1]; r[6] = hi[2]; r[7] = hi[3]; return r; }
__device__ __forceinline__ bf16x8 lds_frag_perm(const LAS unsigned char* rowp_kbase, int g) {
    const s16x4 lo = *(const LAS s16x4*)(rowp_kbase + 8 * g), hi = *(const LAS s16x4*)(rowp_kbase + 32 + 8 * g);
    return cat44(lo, hi);
}
__device__ __forceinline__ bf16x8 acc_to_bfrag(const f32x4 t0, const f32x4 t1) {
    v4u w; w.x = pk2(t0[0], t0[1]); w.y = pk2(t0[2], t0[3]); w.z = pk2(t1[0], t1[1]); w.w = pk2(t1[2], t1[3]);
    return __builtin_bit_cast(bf16x8, w);
}

constexpr int P2_QT = 0, P2_KT = 17408, P2_KBT = 34816, P2_VB = 52224, P2_LM = 86016, P2_SSQ = 102400, P2_SCAL = 110592, P2_LB = 112640, P2_DINV = 121856;
constexpr int P2_RS = 272;
struct P2Regs { float w[4][8]; v4u xr[11]; float braw[8]; float b7, a7; };
__device__ __forceinline__ void p2_decode(int it, int& b, int& h, int& n, int& row0, int& nreal, bool& samp) {
    samp = it >= 1024;
    if (!samp) { const int bh = it >> 5; b = bh >> 2; h = bh & 3; n = it & 31; row0 = b * T + 64 * n; nreal = 64; }
    else { b = (it - 1024) >> 2; h = (it - 1024) & 3; n = 0; row0 = MP + 16 * b; nreal = 16; }
}
template <int NR, int SEC>
__device__ __forceinline__ void p2_pass_load(P2Regs& R, const Args& A, const bf16* QKVA, const float* SM, int rbase, int cc, int it, bool loadw) {
    int b, h, n, row0, nreal; bool samp; p2_decode(it, b, h, n, row0, nreal, samp);
    const int col = SEC * 512 + h * 128 + 8 * cc;
    if (loadw) {
#pragma unroll
        for (int j = 0; j < 4; ++j) { const f32x4 a = *(const GAS f32x4*)(A.in[12] + j * 1536 + col), c = *(const GAS f32x4*)(A.in[12] + j * 1536 + col + 4);
            R.w[j][0] = a[0]; R.w[j][1] = a[1]; R.w[j][2] = a[2]; R.w[j][3] = a[3]; R.w[j][4] = c[0]; R.w[j][5] = c[1]; R.w[j][6] = c[2]; R.w[j][7] = c[3]; }
    }
    if (samp) {
#pragma unroll
        for (int j = 0; j < NR + 3; ++j) {
            const int rr = rbase + j - 3;
            const int rh = rr < 0 ? 3 + rr : 0;
            const float* sp = A.in[2] + (size_t)(b * 3 + rh) * 1536 + col;
            const f32x4 a = *(const GAS f32x4*)sp, c = *(const GAS f32x4*)(sp + 4);
            const int rc = rr < 0 ? 0 : (rr < 16 ? rr : 15);
            const v4u q = *(const GAS v4u*)(QKVA + (size_t)(row0 + rc) * 1536 + col);
            const v4u hst = pack8(a, c);
            R.xr[j] = rr < 0 ? hst : (rr < 16 ? q : (v4u){0u, 0u, 0u, 0u});
        }
    } else {
#pragma unroll
        for (int j = 0; j < NR + 3; ++j) {
            const int rr = rbase + j - 3;
            const bool zero = rr < 0 && n == 0;
            const v4u q = *(const GAS v4u*)(QKVA + (size_t)(row0 + (zero ? 0 : rr)) * 1536 + col);
            R.xr[j] = zero ? (v4u){0u, 0u, 0u, 0u} : q;
        }
    }
    if (SEC != 0) { const int rr = rbase + (cc & (NR - 1)); R.braw[0] = SM[(size_t)(row0 + (rr < nreal ? rr : 0)) * 16 + h]; }
}
template <int NR, int SEC>
__device__ __forceinline__ void p2_pass_compute(const P2Regs& R, LAS unsigned char* L, int rbase, int cc, int nreal, int lane) {
#pragma unroll
    for (int r = 0; r < NR; ++r) {
        const int row = rbase + r;
        const bool real = row < nreal;
        const float rmask = real ? 1.f : 0.f;
        float val[8]; float p = 0.f;
#pragma unroll
        for (int e = 0; e < 8; ++e) {
            const int wd = e >> 1; const bool hi = e & 1;
            const float x0 = hi ? bfhi(R.xr[r][wd]) : bflo(R.xr[r][wd]), x1 = hi ? bfhi(R.xr[r + 1][wd]) : bflo(R.xr[r + 1][wd]);
            const float x2 = hi ? bfhi(R.xr[r + 2][wd]) : bflo(R.xr[r + 2][wd]), x3 = hi ? bfhi(R.xr[r + 3][wd]) : bflo(R.xr[r + 3][wd]);
            float y = R.w[0][e] * x0 + R.w[1][e] * x1 + R.w[2][e] * x2 + R.w[3][e] * x3;
            y = silu_f(y) * rmask;
            val[e] = y; if (SEC != 2) p += y * y;
        }
        float rs = 0.f;
        if (SEC != 2) {
            p += __builtin_bit_cast(float, __builtin_amdgcn_update_dpp(0, __builtin_bit_cast(int, p), 0x128, 0xf, 0xf, false));
            p += __builtin_bit_cast(float, __builtin_amdgcn_update_dpp(0, __builtin_bit_cast(int, p), 0x124, 0xf, 0xf, false));
            p += __builtin_bit_cast(float, __builtin_amdgcn_update_dpp(0, __builtin_bit_cast(int, p), 0x122, 0xf, 0xf, false));
            p += __builtin_bit_cast(float, __builtin_amdgcn_update_dpp(0, __builtin_bit_cast(int, p), 0x121, 0xf, 0xf, false));
            rs = __builtin_amdgcn_rsqf(p + EPS);
        }
        float be = 0.f;
        if (SEC != 0) { const float br = __shfl(R.braw[0], (lane & 48) + r); be = frcp(1.0f + fexp2(-1.4426950408889634f * br)) * rmask; }
        if (SEC == 0) {
            const float sc = rs * 0.08838834764831845f;
            v4u o; o.x = pk2(val[0] * sc, val[1] * sc); o.y = pk2(val[2] * sc, val[3] * sc); o.z = pk2(val[4] * sc, val[5] * sc); o.w = pk2(val[6] * sc, val[7] * sc);
            *(LAS v4u*)(L + P2_QT + row * P2_RS + 16 * cc) = o;
        } else if (SEC == 1) {
            const float bs = be * rs;
            v4u o; o.x = pk2(val[0] * rs, val[1] * rs); o.y = pk2(val[2] * rs, val[3] * rs); o.z = pk2(val[4] * rs, val[5] * rs); o.w = pk2(val[6] * rs, val[7] * rs);
            *(LAS v4u*)(L + P2_KT + row * P2_RS + 16 * cc) = o;
            v4u q; q.x = pk2(val[0] * bs, val[1] * bs); q.y = pk2(val[2] * bs, val[3] * bs); q.z = pk2(val[4] * bs, val[5] * bs); q.w = pk2(val[6] * bs, val[7] * bs);
            *(LAS v4u*)(L + P2_KBT + row * P2_RS + 16 * cc) = q;
        } else {
            LAS float* vp = (LAS float*)(L + P2_VB) + row * 132 + 8 * cc;
            *(LAS f32x4*)vp = (f32x4){val[0] * be, val[1] * be, val[2] * be, val[3] * be};
            *(LAS f32x4*)(vp + 4) = (f32x4){val[4] * be, val[5] * be, val[6] * be, val[7] * be};
        }
    }
}
template <bool ISU>
__device__ __forceinline__ void p2_solve(Frame& F, LAS unsigned char* L, const LAS float* scal, int it, int wave, int g, int c) {
        const f32x4 z4 = {0.f, 0.f, 0.f, 0.f};
        f32x4 X[2][4];
#pragma unroll
        for (int I = 0; I < 4; ++I) {
            f32x4 R[2];
#pragma unroll
            for (int tq = 0; tq < 2; ++tq) {
                const int col = 16 * ((2 * wave + tq) & 7) + c;
#pragma unroll
                for (int r = 0; r < 4; ++r) { const int i = 16 * I + 4 * g + r;
                    R[tq][r] = ISU ? ((const LAS float*)(L + P2_VB))[i * 132 + col] : bf2f(*(const LAS unsigned short*)(L + P2_KBT + i * P2_RS + 2 * col)) * scal[128 + i]; }
            }
            const LAS unsigned char* Lrow = L + P2_LB + (16 * I + c) * 144;
            bf16x8 la = {}, lb = {};
            if (I >= 1) la = lds_frag_perm(Lrow, g);
            if (I == 3) lb = lds_frag_perm(Lrow + 64, g);
            const s16x4 dlo = *(const LAS s16x4*)(L + P2_DINV + (16 * I + c) * 40 + 8 * g);
            const bf16x8 da = cat44(dlo, (s16x4){0, 0, 0, 0});
#pragma unroll
            for (int tq = 0; tq < 2; ++tq) {
                if (I == 1) R[tq] = MFMA16(la, acc_to_bfrag(X[tq][0], z4), R[tq]);
                if (I >= 2) R[tq] = MFMA16(la, acc_to_bfrag(X[tq][0], X[tq][1]), R[tq]);
                if (I == 3) R[tq] = MFMA16(lb, acc_to_bfrag(X[tq][2], z4), R[tq]);
            }
            f32x4 Rh[2], Rl[2];
#pragma unroll
            for (int tq = 0; tq < 2; ++tq)
#pragma unroll
                for (int r = 0; r < 4; ++r) { Rh[tq][r] = bf2f((unsigned short)f2bf(R[tq][r])); Rl[tq][r] = R[tq][r] - Rh[tq][r]; }
#pragma unroll
            for (int tq = 0; tq < 2; ++tq) X[tq][I] = MFMA16(da, acc_to_bfrag(Rh[tq], z4), z4);
#pragma unroll
            for (int tq = 0; tq < 2; ++tq) X[tq][I] = MFMA16(da, acc_to_bfrag(Rl[tq], z4), X[tq][I]);
#pragma unroll
            for (int tq = 0; tq < 2; ++tq) {
                const int col = 16 * ((2 * wave + tq) & 7) + c;
                bf16* dst = (ISU ? (bf16*)(F.ws + WS_GU0) : (bf16*)(F.ws + WS_GWK)) + (size_t)it * 8192 + col;
#pragma unroll
                for (int r = 0; r < 4; ++r)
                    dst[(16 * I + 4 * g + r) * 128] = (bf16)f2bf(ISU ? X[tq][I][r] : -X[tq][I][r]);
            }
        }
}
__device__ __forceinline__ void p2_load_all(P2Regs& R, Frame& F, const Args& A, int it, int tid, int wave, int lane, bool loadw) {
    const bf16* QKVA = (const bf16*)(F.ws + WS_QKVA); const float* SM = (const float*)(F.ws + WS_SMALL);
    const int k4 = (tid >> 4) & 3, cc = tid & 15;
    if (wave < 2) p2_pass_load<8, 0>(R, A, QKVA, SM, 8 * (4 * wave + k4), cc, it, loadw);
    else if (wave < 4) p2_pass_load<8, 1>(R, A, QKVA, SM, 8 * (4 * (wave - 2) + k4), cc, it, loadw);
    else p2_pass_load<4, 2>(R, A, QKVA, SM, 4 * (4 * (wave - 4) + k4), cc, it, loadw);
    R.b7 = 0.f; R.a7 = 0.f;
    if (wave == 7) { int b, h, n, row0, nreal; bool samp; p2_decode(it, b, h, n, row0, nreal, samp);
        if (lane < nreal) { R.b7 = SM[(size_t)(row0 + lane) * 16 + h]; R.a7 = SM[(size_t)(row0 + lane) * 16 + 4 + h]; } }
}
__device__ __forceinline__ void p2_body(Frame& F, const Args& A, int it, int itnext, P2Regs& R, int tid) {
    const int lane = tid & 63, wave = __builtin_amdgcn_readfirstlane(tid >> 6);
    LAS unsigned char* L = F.lds;
    LAS float* ssq = (LAS float*)(L + P2_SSQ);
    LAS float* scal = (LAS float*)(L + P2_SCAL);
    const bool samp = it >= 1024;
    int b, h, n, row0, nreal;
    if (!samp) { const int bh = it >> 5; b = bh >> 2; h = bh & 3; n = it & 31; row0 = b * T + 64 * n; nreal = 64; }
    else { b = (it - 1024) >> 2; h = (it - 1024) & 3; n = 0; row0 = MP + 16 * b; nreal = 16; }
    const bf16* QKVA = (const bf16*)(F.ws + WS_QKVA);
    const float* SM = (const float*)(F.ws + WS_SMALL);
    const float* par = (const float*)(F.ws + WS_PAR);

    const float braw7 = R.b7, araw7 = R.a7;
    {
        const int k4 = (tid >> 4) & 3, cc = tid & 15;
        if (wave < 2) p2_pass_compute<8, 0>(R, L, 8 * (4 * wave + k4), cc, nreal, lane);
        else if (wave < 4) p2_pass_compute<8, 1>(R, L, 8 * (4 * (wave - 2) + k4), cc, nreal, lane);
        else p2_pass_compute<4, 2>(R, L, 4 * (4 * (wave - 4) + k4), cc, nreal, lane);
    }
    if (wave == 7) {
        float be = 0.f, g = 0.f;
        if (lane < nreal) {
            be = 1.0f / (1.0f + expf(-braw7));
            const float z = araw7 + par[PAR_DTB + h]; const float sp = z > 20.f ? z : log1pf(expf(z));
            g = -expf(par[PAR_ALOG + h]) * sp;
        }
        float gc = g;
#pragma unroll
        for (int o = 1; o < 64; o <<= 1) { const float t = __shfl_up(gc, o); if (lane >= o) gc += t; }
        const float gl = __shfl(gc, 63);
        scal[lane] = be; scal[64 + lane] = gc; scal[128 + lane] = expf(gc); scal[192 + lane] = expf(gl - gc);
        if (lane == 0) ((float*)(F.ws + WS_GLAST))[it] = expf(gl);
    }
    __syncthreads();

    if (itnext < NGITEM) {
        int b2, h2, n2, r2, nr2; bool s2; p2_decode(itnext, b2, h2, n2, r2, nr2, s2);
        p2_load_all(R, F, A, itnext, tid, wave, lane, h2 != h);
    }
    {
        const int g = lane >> 4, c = lane & 15;
        bf16* GQK = (bf16*)(F.ws + WS_GQK) + (size_t)it * 4096;
        LAS float* Lm = (LAS float*)(L + P2_LM);
#pragma unroll
        for (int q = 0; q < 3; ++q) {
            const int job = wave + 8 * q;
            if (job >= 20) break;
            const int tt = job >> 1; const bool isqk = job & 1;
            const int ti = tt < 1 ? 0 : (tt < 3 ? 1 : (tt < 6 ? 2 : 3)), tj = tt - (ti * (ti + 1)) / 2;
            f32x4 acc = {0.f, 0.f, 0.f, 0.f};
            {
                const LAS unsigned char* Ap = L + (isqk ? P2_QT : P2_KBT) + (16 * ti + c) * P2_RS + 16 * g;
                const LAS unsigned char* Bp = L + P2_KT + (16 * tj + c) * P2_RS + 16 * g;
#pragma unroll
                for (int ks = 0; ks < 4; ++ks) acc = MFMA16(lds_frag16(Ap + 64 * ks), lds_frag16(Bp + 64 * ks), acc);
            }
            const int j = 16 * tj + c; const float gcj = scal[64 + j];
#pragma unroll
            for (int r = 0; r < 4; ++r) {
                const int i = 16 * ti + 4 * g + r;
                const float dec = fexp2(1.4426950408889634f * fminf(scal[64 + i] - gcj, 0.f));
                if (!isqk) { const float lv = (j < i) ? acc[r] * dec : 0.f; Lm[i * 64 + j] = lv; *(LAS unsigned short*)(L + P2_LB + i * 144 + 2 * j) = (unsigned short)f2bf(-lv); }
                else GQK[i * 64 + j] = (bf16)f2bf((j <= i) ? acc[r] * dec : 0.f);
            }
        }
        if (wave >= 2) {
            const int z = wave - 2, ti = z < 3 ? 0 : (z < 5 ? 1 : 2), tj = z < 3 ? z + 1 : (z < 5 ? z - 1 : 3);
#pragma unroll
            for (int r = 0; r < 4; ++r) GQK[(16 * ti + 4 * g + r) * 64 + 16 * tj + c] = (bf16)0;
        }
    }
    __syncthreads();

    if (tid < 64) {
        const int I = tid >> 4, jj = tid & 15;
        const LAS float* Ld = (const LAS float*)(L + P2_LM) + (16 * I) * 64 + 16 * I;
        float t[16];
#pragma unroll
        for (int ii = 0; ii < 16; ++ii) {
            float r = ii == jj ? 1.f : 0.f;
#pragma unroll
            for (int k4 = 0; k4 < (ii + 3) / 4; ++k4) {
                const f32x4 l4 = *(const LAS f32x4*)(Ld + ii * 64 + 4 * k4);
                r -= l4[0] * t[4 * k4];
                if (4 * k4 + 1 < ii) r -= l4[1] * t[4 * k4 + 1];
                if (4 * k4 + 2 < ii) r -= l4[2] * t[4 * k4 + 2];
                if (4 * k4 + 3 < ii) r -= l4[3] * t[4 * k4 + 3];
            }
            t[ii] = r;
            *(LAS unsigned short*)(L + P2_DINV + (16 * I + ii) * 40 + 2 * jj) = (unsigned short)f2bf(r);
        }
    } else if (tid >= 256) {
        const int t2 = tid - 256;
        bf16* GQD = (bf16*)(F.ws + WS_GQD) + (size_t)it * 8192;
        bf16* GKDT = (bf16*)(F.ws + WS_GKDT) + (size_t)it * 8192;
#pragma unroll
        for (int q = 0; q < 4; ++q) {
            const int ch = t2 + 256 * q, row = ch >> 4, c16 = ch & 15; const float e = scal[128 + row];
            const v4u u = *(const LAS v4u*)(L + P2_QT + row * P2_RS + 16 * c16);
            v4u o; o.x = pk2(bflo(u.x) * e, bfhi(u.x) * e); o.y = pk2(bflo(u.y) * e, bfhi(u.y) * e); o.z = pk2(bflo(u.z) * e, bfhi(u.z) * e); o.w = pk2(bflo(u.w) * e, bfhi(u.w) * e);
            *(GAS v4u*)(GQD + row * 128 + 8 * c16) = o;
        }
        {
            const int d = t2 >> 1, i0 = 32 * (t2 & 1);
#pragma unroll
            for (int q = 0; q < 4; ++q) {
                float v[8];
#pragma unroll
                for (int e = 0; e < 8; ++e) { const int i = i0 + 8 * q + e; v[e] = bf2f(*(const LAS unsigned short*)(L + P2_KT + i * P2_RS + 2 * d)) * scal[192 + i]; }
                v4u o; o.x = pk2(v[0], v[1]); o.y = pk2(v[2], v[3]); o.z = pk2(v[4], v[5]); o.w = pk2(v[6], v[7]);
                *(GAS v4u*)(GKDT + d * 64 + i0 + 8 * q) = o;
            }
        }
    }
    __syncthreads();

    {
        const int g = lane >> 4, c = lane & 15;
        const f32x4 z4 = {0.f, 0.f, 0.f, 0.f};
        if (wave < 4) p2_solve<true>(F, L, scal, it, wave, g, c); else p2_solve<false>(F, L, scal, it, wave, g, c);
    }
    __syncthreads();

}

__device__ __forceinline__ void p2_static(Frame& F, const Args& A) {
    int tid = F.tid; asm volatile("" : "+v"(tid));
    const int lane = tid & 63, wave = __builtin_amdgcn_readfirstlane(tid >> 6);
    P2Regs R;
    int it = F.vcu;
    if (it < NGITEM) p2_load_all(R, F, A, it, tid, wave, lane, true);
#pragma unroll 1
    for (; it < NGITEM; it += F.G) p2_body(F, A, it, it + F.G, R, tid);
}

constexpr int SC_WK = 0, SC_QD = 17408, SC_U0 = 34816, SC_KDT = 44032, SC_QK = 62464;
constexpr int SC_RS = 272, SC_RS2 = 144, SC_BUF = 71680;
__device__ __forceinline__ void scan_item(Frame& F, const Args& A, int bh, int half, bool samp) {
    int tid = F.tid; asm volatile("" : "+v"(tid));
    const int lane = tid & 63, wave = __builtin_amdgcn_readfirstlane(tid >> 6), g = lane >> 4, c = lane & 15;
    LAS unsigned char* L = F.lds;
    const int b = bh >> 2, h = bh & 3;
    const int nsteps = samp ? 1 : 32;
    const int it0 = samp ? 1024 + bh : bh * 32;
    const int row0 = samp ? MP + 16 * b : b * T;
    const int itlast = it0 + nsteps - 1;
    const bool helper = wave >= 4;
    const int dv0 = 64 * half + 16 * (wave & 3);
    const int ht = tid - 256;
    v4u preA[16], preB[16];
#define SCAN_LOAD(pre, itm) do { \
        const bf16* pwk = (const bf16*)(F.ws + WS_GWK) + (size_t)(itm) * 8192; const bf16* pqd = (const bf16*)(F.ws + WS_GQD) + (size_t)(itm) * 8192; \
        const bf16* pu0 = (const bf16*)(F.ws + WS_GU0) + (size_t)(itm) * 8192 + 64 * half; const bf16* pkd = (const bf16*)(F.ws + WS_GKDT) + (size_t)(itm) * 8192; \
        const bf16* pqk = (const bf16*)(F.ws + WS_GQK) + (size_t)(itm) * 4096; \
        _Pragma("unroll") for (int i = 0; i < 4; ++i) { pre[i] = *(const GAS v4u*)(pwk + 8 * (ht + 256 * i)); pre[4 + i] = *(const GAS v4u*)(pqd + 8 * (ht + 256 * i)); pre[10 + i] = *(const GAS v4u*)(pkd + 8 * (ht + 256 * i)); } \
        _Pragma("unroll") for (int i = 0; i < 2; ++i) { const int q = ht + 256 * i; pre[8 + i] = *(const GAS v4u*)(pu0 + (q >> 3) * 128 + 8 * (q & 7)); pre[14 + i] = *(const GAS v4u*)(pqk + 8 * q); } } while (0)
#define SCAN_ST2(dst, val_) do { LAS unsigned char* d_ = (dst); const v4u v_ = (val_); *(LAS v2u*)d_ = (v2u){v_.x, v_.y}; *(LAS v2u*)(d_ + 16) = (v2u){v_.z, v_.w}; } while (0)
#define SCAN_POFF(c_) (64 * ((c_) >> 2) + 8 * (4 * ((c_) & 1) + (((c_) & 3) >> 1)))
#define SCAN_STORE(pre, Lb) do { \
        _Pragma("unroll") for (int i = 0; i < 4; ++i) { const int q = ht + 256 * i, row = q >> 4, c16 = q & 15; \
            SCAN_ST2((Lb) + SC_WK + row * SC_RS + SCAN_POFF(c16), pre[i]); SCAN_ST2((Lb) + SC_QD + row * SC_RS + SCAN_POFF(c16), pre[4 + i]); \
            const int row2 = q >> 3, c8 = q & 7; SCAN_ST2((Lb) + SC_KDT + row2 * SC_RS2 + SCAN_POFF(c8), pre[10 + i]); } \
        _Pragma("unroll") for (int i = 0; i < 2; ++i) { const int q = ht + 256 * i, row2 = q >> 3, c8 = q & 7; \
            *(LAS v4u*)((Lb) + SC_U0 + row2 * SC_RS2 + 16 * c8) = pre[8 + i]; SCAN_ST2((Lb) + SC_QK + row2 * SC_RS2 + SCAN_POFF(c8), pre[14 + i]); } } while (0)
    if (helper) {
#define SCAN_CL(i_) ((i_) <= itlast ? (i_) : itlast)
        SCAN_LOAD(preA, it0);
        SCAN_LOAD(preB, SCAN_CL(it0 + 1));
        SCAN_STORE(preA, L);
        SCAN_LOAD(preA, SCAN_CL(it0 + 2));
        __syncthreads();
        for (int n = 0; n < nsteps; n += 2) {
            if (n + 1 < nsteps) SCAN_STORE(preB, L + SC_BUF);
            SCAN_LOAD(preB, SCAN_CL(it0 + n + 3));
            __syncthreads();
            if (n + 1 < nsteps) {
                if (n + 2 < nsteps) SCAN_STORE(preA, L);
                SCAN_LOAD(preA, SCAN_CL(it0 + n + 4));
                __syncthreads();
            }
        }
#undef SCAN_CL
    } else {
        f32x4 S[8];
        if (samp) {
            const float* s0 = A.in[3] + (size_t)bh * 16384;
#pragma unroll
            for (int t = 0; t < 8; ++t)
#pragma unroll
                for (int r = 0; r < 4; ++r) S[t][r] = s0[(16 * t + 4 * g + r) * 128 + dv0 + c];
        } else {
#pragma unroll
            for (int t = 0; t < 8; ++t) S[t] = (f32x4){0.f, 0.f, 0.f, 0.f};
        }
        float glv = ((const float*)(F.ws + WS_GLAST))[it0 + (lane < nsteps ? lane : nsteps - 1)];
#pragma unroll
        for (int t = 0; t < 8; ++t)
#pragma unroll
            for (int r = 0; r < 4; ++r) { float x = S[t][r]; asm volatile("" : "+v"(x)); S[t][r] = x; }
        asm volatile("" : "+v"(glv));
        float last = __builtin_bit_cast(float, __builtin_amdgcn_readlane(__builtin_bit_cast(int, glv), 0));
        unsigned short* op = (unsigned short*)(F.ws + WS_OA) + (size_t)(row0 + 4 * g) * 512 + h * 128 + dv0 + c;
        __syncthreads();
        for (int n = 0; n < nsteps; ++n) {
            const LAS unsigned char* Lc = L + (n & 1) * SC_BUF;
            const float lastn = __builtin_bit_cast(float, __builtin_amdgcn_readlane(__builtin_bit_cast(int, glv), n + 1 < nsteps ? n + 1 : nsteps - 1));
            bf16x8 BS[4];
#pragma unroll
            for (int ks = 0; ks < 4; ++ks) BS[ks] = acc_to_bfrag(S[2 * ks], S[2 * ks + 1]);
            f32x4 u[4], o[4];
#pragma unroll
            for (int tt = 0; tt < 4; ++tt) {
                bf16x8 af[8];
#pragma unroll
                for (int ks = 0; ks < 4; ++ks) { af[ks] = lds_frag16(Lc + SC_WK + (16 * tt + c) * SC_RS + 64 * ks + 16 * g); af[4 + ks] = lds_frag16(Lc + SC_QD + (16 * tt + c) * SC_RS + 64 * ks + 16 * g); }
#pragma unroll
                for (int r = 0; r < 4; ++r) u[tt][r] = bf2f(*(const LAS unsigned short*)(Lc + SC_U0 + (16 * tt + 4 * g + r) * SC_RS2 + 2 * (16 * (wave & 3) + c)));
                o[tt] = (f32x4){0.f, 0.f, 0.f, 0.f};
                __builtin_amdgcn_sched_barrier(0);
#pragma unroll
                for (int ks = 0; ks < 4; ++ks) { u[tt] = MFMA16(af[ks], BS[ks], u[tt]); o[tt] = MFMA16(af[4 + ks], BS[ks], o[tt]); }
                __builtin_amdgcn_sched_barrier(0);
            }
            bf16x8 BU[2];
            BU[0] = acc_to_bfrag(u[0], u[1]); BU[1] = acc_to_bfrag(u[2], u[3]);
            {
                bf16x8 af[8];
#pragma unroll
                for (int tt = 0; tt < 4; ++tt)
#pragma unroll
                    for (int k2 = 0; k2 < 2; ++k2) af[2 * tt + k2] = lds_frag16(Lc + SC_QK + (16 * tt + c) * SC_RS2 + 64 * k2 + 16 * g);
                __builtin_amdgcn_sched_barrier(0);
#pragma unroll
                for (int tt = 0; tt < 4; ++tt)
#pragma unroll
                    for (int k2 = 0; k2 < 2; ++k2) o[tt] = MFMA16(af[2 * tt + k2], BU[k2], o[tt]);
                __builtin_amdgcn_sched_barrier(0);
            }
#pragma unroll
            for (int th = 0; th < 2; ++th) {
                bf16x8 af[8];
#pragma unroll
                for (int t4 = 0; t4 < 4; ++t4)
#pragma unroll
                    for (int k2 = 0; k2 < 2; ++k2) af[2 * t4 + k2] = lds_frag16(Lc + SC_KDT + (16 * (4 * th + t4) + c) * SC_RS2 + 64 * k2 + 16 * g);
#pragma unroll
                for (int t4 = 0; t4 < 4; ++t4) S[4 * th + t4] = S[4 * th + t4] * last;
                __builtin_amdgcn_sched_barrier(0);
#pragma unroll
                for (int t4 = 0; t4 < 4; ++t4)
#pragma unroll
                    for (int k2 = 0; k2 < 2; ++k2) S[4 * th + t4] = MFMA16(af[2 * t4 + k2], BU[k2], S[4 * th + t4]);
                __builtin_amdgcn_sched_barrier(0);
            }
            last = lastn;
            if (!samp) {
#pragma unroll
                for (int tt = 0; tt < 4; ++tt)
#pragma unroll
                    for (int r = 0; r < 4; ++r) op[(size_t)(16 * tt + r) * 512] = (unsigned short)f2bf(o[tt][r]);
                op += (size_t)64 * 512;
            } else {
#pragma unroll
                for (int r = 0; r < 4; ++r) op[(size_t)r * 512] = (unsigned short)f2bf(o[0][r]);
            }
            __syncthreads();
        }
        float* so = F.out + (samp ? OFF_SSSM : OFF_PSSM) + (size_t)bh * 16384;
#pragma unroll
        for (int t = 0; t < 8; ++t)
#pragma unroll
            for (int r = 0; r < 4; ++r) so[(16 * t + 4 * g + r) * 128 + dv0 + c] = S[t][r];
    }
    asm volatile("s_waitcnt vmcnt(0)" ::: "memory");
    __syncthreads();
    if (tid == 0) {
        __builtin_amdgcn_fence(__ATOMIC_RELEASE, "agent");
        asm volatile("s_waitcnt vmcnt(0)" ::: "memory");
        __hip_atomic_fetch_add(F.ctl + CW_GATE + 64 * ((samp ? 32 : 0) + bh), 1u, __ATOMIC_RELAXED, __HIP_MEMORY_SCOPE_AGENT);
    }
    __syncthreads();
#undef SCAN_LOAD
#undef SCAN_STORE
#undef SCAN_ST2
#undef SCAN_POFF
}

__device__ __forceinline__ void gate_item(Frame& F, int bh, int part) {
    int tid = F.tid; asm volatile("" : "+v"(tid));
    const int lane = tid & 63, wave = __builtin_amdgcn_readfirstlane(tid >> 6);
    const int b = bh >> 2, h = bh & 3;
    const bool samp = part == 8;
    if (tid == 0) {
        gu32* flag = F.ctl + CW_GATE + 64 * ((samp ? 32 : 0) + bh);
        unsigned sp = 0;
        while (__hip_atomic_load(flag, RLX_AGENT) < 2u) {
            __builtin_amdgcn_s_sleep(2);
            if (++sp > (1u << 22)) { __hip_atomic_store(F.ctl + CW_TMO, 0x6a7eu, RLX_AGENT); break; }
        }
        __builtin_amdgcn_fence(__ATOMIC_ACQUIRE, "agent");
        asm volatile("s_waitcnt vmcnt(0)" ::: "memory");
    }
    __syncthreads();
    const bf16* OA = (const bf16*)(F.ws + WS_OA); const bf16* ZA = (const bf16*)(F.ws + WS_ZA); bf16* MIX = (bf16*)(F.ws + WS_MIX);
    const float* go = (const float*)(F.ws + WS_PAR) + PAR_GO;
    const float g0 = go[2 * lane], g1 = go[2 * lane + 1];
    const int row0 = samp ? MP + 16 * b : b * T + 256 * part;
    const int nrow = samp ? 2 : 32;
#pragma unroll 1
    for (int i0 = 0; i0 < nrow; i0 += 32) {
        float2 o[32]; unsigned z[32];
#pragma unroll
        for (int i = 0; i < 32; ++i) { const int row = row0 + wave * nrow + (i0 + i < nrow ? i0 + i : nrow - 1);
            { const unsigned ow = *(const unsigned*)(OA + (size_t)row * 512 + h * 128 + 2 * lane); o[i].x = bflo(ow); o[i].y = bfhi(ow); } z[i] = *(const unsigned*)(ZA + (size_t)row * 512 + h * 128 + 2 * lane); }
#pragma unroll
        for (int i = 0; i < 32; ++i) {
            float x = o[i].x * o[i].x + o[i].y * o[i].y;
            x += __builtin_bit_cast(float, __builtin_amdgcn_update_dpp(0, __builtin_bit_cast(int, x), 0x111, 0xf, 0xf, false));
            x += __builtin_bit_cast(float, __builtin_amdgcn_update_dpp(0, __builtin_bit_cast(int, x), 0x112, 0xf, 0xf, false));
            x += __builtin_bit_cast(float, __builtin_amdgcn_update_dpp(0, __builtin_bit_cast(int, x), 0x114, 0xf, 0xf, false));
            x += __builtin_bit_cast(float, __builtin_amdgcn_update_dpp(0, __builtin_bit_cast(int, x), 0x118, 0xf, 0xf, false));
            x += __builtin_bit_cast(float, __builtin_amdgcn_update_dpp(0, __builtin_bit_cast(int, x), 0x142, 0xa, 0xf, false));
            x += __builtin_bit_cast(float, __builtin_amdgcn_update_dpp(0, __builtin_bit_cast(int, x), 0x143, 0xc, 0xf, false));
            const float ss = __builtin_bit_cast(float, __builtin_amdgcn_readlane(__builtin_bit_cast(int, x), 63));
            const float rs = 1.0f / sqrtf(ss * (1.f / 128.f) + EPS);
            if (i0 + i < nrow) { const int row = row0 + wave * nrow + i0 + i;
                *(unsigned*)(MIX + (size_t)row * DM + h * 128 + 2 * lane) = pk2(o[i].x * rs * g0 * bflo(z[i]), o[i].y * rs * g1 * bfhi(z[i])); }
        }
    }
    __syncthreads();
}

__device__ __forceinline__ unsigned fkey(float f) { const unsigned u = __builtin_bit_cast(unsigned, f + 0.0f); return (u & 0x80000000u) ? ~u : (u | 0x80000000u); }
template <int S, unsigned M> __device__ __forceinline__ void tr_stage(unsigned (&a)[32]) {
#pragma unroll
    for (int k = 0; k < 32; ++k) if ((k & S) == 0) { const unsigned t = ((a[k] >> S) ^ a[k + S]) & M; a[k + S] ^= t; a[k] ^= t << S; }
}
__device__ __forceinline__ void transpose32(unsigned (&a)[32]) {
    tr_stage<16, 0x0000ffffu>(a); tr_stage<8, 0x00ff00ffu>(a); tr_stage<4, 0x0f0f0f0fu>(a); tr_stage<2, 0x33333333u>(a); tr_stage<1, 0x55555555u>(a);
}
__device__ __forceinline__ unsigned wave_total_u32(unsigned v) {
    int x = (int)v;
    x += __builtin_amdgcn_update_dpp(0, x, 0x111, 0xf, 0xf, false);
    x += __builtin_amdgcn_update_dpp(0, x, 0x112, 0xf, 0xf, false);
    x += __builtin_amdgcn_update_dpp(0, x, 0x114, 0xf, 0xf, false);
    x += __builtin_amdgcn_update_dpp(0, x, 0x118, 0xf, 0xf, false);
    x += __builtin_amdgcn_update_dpp(0, x, 0x142, 0xa, 0xf, false);
    x += __builtin_amdgcn_update_dpp(0, x, 0x143, 0xc, 0xf, false);
    return (unsigned)__builtin_amdgcn_readlane(x, 63);
}
__device__ __forceinline__ void transpose16x2(unsigned (&a)[16]) {
#define TR16_STAGE(S, M) _Pragma("unroll") for (int k = 0; k < 16; ++k) if ((k & S) == 0) { const unsigned t = ((a[k] >> S) ^ a[k + S]) & M; a[k + S] ^= t; a[k] ^= t << S; }
    TR16_STAGE(8, 0x00ff00ffu) TR16_STAGE(4, 0x0f0f0f0fu) TR16_STAGE(2, 0x33333333u) TR16_STAGE(1, 0x55555555u)
#undef TR16_STAGE
}
template <int NW, bool EXACT>
__device__ __forceinline__ void select_top256(const LAS float* sc, int n, int lane, unsigned (&sel)[NW]) {
    unsigned u[NW][32], alive[NW], gt[NW];
    const int niter = (n + 63) >> 6;
#pragma unroll
    for (int w = 0; w < NW; ++w) {
#pragma unroll
        for (int i = 0; i < 32; ++i) { const int e = 32 * w + i, idx = lane + 64 * e; u[w][i] = (e < niter && (EXACT || idx < n)) ? fkey(sc[idx]) : 0u; }
        unsigned valid = 0u;
        if (EXACT) { const int ne = niter - 32 * w; valid = ne >= 32 ? 0xffffffffu : (ne <= 0 ? 0u : (1u << ne) - 1u); }
        else {
#pragma unroll
            for (int i = 0; i < 32; ++i) { const int e = 32 * w + i; if (e < niter && lane + 64 * e < n) valid |= 1u << i; }
        }
        alive[w] = valid; gt[w] = 0u;
    }
    unsigned above = 0u, calive = (unsigned)n;
    bool done = false;
#pragma unroll
    for (int half = 1; half >= 0; --half) {
        if (!done) {
            unsigned P[NW][16];
#pragma unroll
            for (int w = 0; w < NW; ++w) {
#pragma unroll
                for (int k = 0; k < 16; ++k) P[w][k] = half ? ((u[w][k] >> 16) | (u[w][k + 16] & 0xffff0000u)) : ((u[w][k] & 0xffffu) | (u[w][k + 16] << 16));
                transpose16x2(P[w]);
            }
#pragma unroll
            for (int j = 15; j >= 0; --j) {
                if (!done) {
                    unsigned pc = 0u;
#pragma unroll
                    for (int w = 0; w < NW; ++w) pc += (unsigned)__builtin_popcount(alive[w] & P[w][j]);
                    const unsigned c1 = wave_total_u32(pc);
                    const bool one = above + c1 >= 256u;
                    if (one) calive = c1; else { above += c1; calive -= c1; }
#pragma unroll
                    for (int w = 0; w < NW; ++w) { const unsigned ones = alive[w] & P[w][j]; if (one) alive[w] = ones; else { gt[w] |= ones; alive[w] &= ~P[w][j]; } }
                    done = (calive + above == 256u);
                }
            }
        }
    }
    unsigned pc = 0u;
#pragma unroll
    for (int w = 0; w < NW; ++w) pc += (unsigned)__builtin_popcount(alive[w]);
    const unsigned nties = wave_total_u32(pc);
    unsigned rem = 256u - above;
    if (rem < nties) {
#pragma unroll
        for (int w = 0; w < NW; ++w)
#pragma unroll 1
            for (int i = 0; i < 32; ++i) {
                const bool mine = (alive[w] >> i) & 1u;
                const unsigned long long eq = __ballot(mine);
                const unsigned ce = (unsigned)__builtin_popcountll(eq);
                if (ce <= rem) rem -= ce;
                else { const unsigned rank = (unsigned)__builtin_popcountll(eq & ((1ull << lane) - 1ull)); if (mine && rank >= rem) alive[w] &= ~(1u << i); rem = 0u; }
            }
    }
#pragma unroll
    for (int w = 0; w < NW; ++w) sel[w] = gt[w] | alive[w];
}

__device__ __forceinline__ void select_top256_x2(const LAS float* sc0, const LAS float* sc1, int n, int lane, unsigned& sel0, unsigned& sel1) {
    unsigned u[2][32], alive[2], gt[2] = {0u, 0u}, above[2] = {0u, 0u}, calive[2];
    bool done[2] = {false, false};
    const int niter = n >> 6;
#pragma unroll
    for (int i = 0; i < 32; ++i) { const int idx = lane + 64 * i; u[0][i] = i < niter ? fkey(sc0[idx]) : 0u; u[1][i] = i < niter ? fkey(sc1[idx]) : 0u; }
    alive[0] = alive[1] = niter >= 32 ? 0xffffffffu : (1u << niter) - 1u;
    calive[0] = calive[1] = (unsigned)n;
#pragma unroll
    for (int half = 1; half >= 0; --half) {
        if (!(done[0] && done[1])) {
            unsigned P[2][16];
#pragma unroll
            for (int q = 0; q < 2; ++q) {
#pragma unroll
                for (int k = 0; k < 16; ++k) P[q][k] = half ? ((u[q][k] >> 16) | (u[q][k + 16] & 0xffff0000u)) : ((u[q][k] & 0xffffu) | (u[q][k + 16] << 16));
                transpose16x2(P[q]);
            }
#pragma unroll
            for (int j = 15; j >= 0; --j) {
                if (!(done[0] && done[1])) {
                    unsigned c1[2];
                    { const unsigned tot = wave_total_u32((unsigned)__builtin_popcount(alive[0] & P[0][j]) | ((unsigned)__builtin_popcount(alive[1] & P[1][j]) << 16));
                      c1[0] = tot & 0xffffu; c1[1] = tot >> 16; }
#pragma unroll
                    for (int q = 0; q < 2; ++q) if (!done[q]) {
                        const bool one = above[q] + c1[q] >= 256u;
                        if (one) calive[q] = c1[q]; else { above[q] += c1[q]; calive[q] -= c1[q]; }
                        const unsigned ones = alive[q] & P[q][j];
                        if (one) alive[q] = ones; else { gt[q] |= ones; alive[q] &= ~P[q][j]; }
                        done[q] = (calive[q] + above[q] == 256u);
                    }
                }
            }
        }
    }
    const unsigned nt2 = wave_total_u32((unsigned)__builtin_popcount(alive[0]) | ((unsigned)__builtin_popcount(alive[1]) << 16));
#pragma unroll
    for (int q = 0; q < 2; ++q) {
        const unsigned nties = q ? nt2 >> 16 : nt2 & 0xffffu;
        unsigned rem = 256u - above[q];
        if (rem < nties) {
#pragma unroll 1
            for (int i = 0; i < 32; ++i) {
                const bool mine = (alive[q] >> i) & 1u;
                const unsigned long long eq = __ballot(mine);
                const unsigned ce = (unsigned)__builtin_popcountll(eq);
                if (ce <= rem) rem -= ce;
                else { const unsigned rank = (unsigned)__builtin_popcountll(eq & ((1ull << lane) - 1ull)); if (mine && rank >= rem) alive[q] &= ~(1u << i); rem = 0u; }
            }
        }
    }
    sel0 = gt[0] | alive[0]; sel1 = gt[1] | alive[1];
}

constexpr int AT_RS = 544;
constexpr int AT_BUF = 64 * AT_RS;
constexpr int AT_K0 = 0, AT_V0 = 2 * AT_BUF;
constexpr int AT_SC = 0;
constexpr int AT_MASK = 4 * AT_BUF;
__device__ __forceinline__ void b1_item(Frame& F, const Args& A, int b, int cch, int sub) {
    int tid = F.tid; asm volatile("" : "+v"(tid));
    const int lane = tid & 63, wave = __builtin_amdgcn_readfirstlane(tid >> 6), g = lane >> 4, c = lane & 15;
    LAS unsigned char* L = F.lds;
    const int n = 64 * (cch + 1);
    const int q0 = b * T + 64 * cch + 16 * sub;
    const bf16* QI = (const bf16*)(F.ws + WS_QI); const bf16* KI = (const bf16*)(F.ws + WS_KI) + (size_t)b * T * 32;
    const float* SM = (const float*)(F.ws + WS_SMALL);
    LAS float* SCs = (LAS float*)(L + AT_SC);
    const int npair = n / 32;
    {
        bf16x8 qa[8];
#pragma unroll
        for (int h = 0; h < 8; ++h) qa[h] = *(const GAS bf16x8*)(QI + (size_t)(q0 + c) * 256 + h * 32 + 8 * g);
        float wq[4][8];
#pragma unroll
        for (int r = 0; r < 4; ++r) { const f32x4 w0 = *(const GAS f32x4*)(SM + (size_t)(q0 + 4 * g + r) * 16 + 8), w1 = *(const GAS f32x4*)(SM + (size_t)(q0 + 4 * g + r) * 16 + 12);
            wq[r][0] = 0.5f * w0[0]; wq[r][1] = 0.5f * w0[1]; wq[r][2] = 0.5f * w0[2]; wq[r][3] = 0.5f * w0[3]; wq[r][4] = 0.5f * w1[0]; wq[r][5] = 0.5f * w1[1]; wq[r][6] = 0.5f * w1[2]; wq[r][7] = 0.5f * w1[3]; }
        bf16x8 qlh, qll;
        {
            const f32x4 c0 = *(const GAS f32x4*)(SM + (size_t)(q0 + c) * 16 + 8), c1 = *(const GAS f32x4*)(SM + (size_t)(q0 + c) * 16 + 12);
            const float wc[8] = {0.5f * c0[0], 0.5f * c0[1], 0.5f * c0[2], 0.5f * c0[3], 0.5f * c1[0], 0.5f * c1[1], 0.5f * c1[2], 0.5f * c1[3]};
            float ql[8] = {0.f, 0.f, 0.f, 0.f, 0.f, 0.f, 0.f, 0.f};
#pragma unroll
            for (int h = 0; h < 8; ++h)
#pragma unroll
                for (int j = 0; j < 8; ++j) ql[j] += wc[h] * bf2f((unsigned short)qa[h][j]);
            float qh[8], qr[8];
#pragma unroll
            for (int j = 0; j < 8; ++j) { qh[j] = bf2f((unsigned short)f2bf(ql[j])); qr[j] = ql[j] - qh[j]; }
            v4u hw, lw;
            hw.x = pk2(qh[0], qh[1]); hw.y = pk2(qh[2], qh[3]); hw.z = pk2(qh[4], qh[5]); hw.w = pk2(qh[6], qh[7]);
            lw.x = pk2(qr[0], qr[1]); lw.y = pk2(qr[2], qr[3]); lw.z = pk2(qr[4], qr[5]); lw.w = pk2(qr[6], qr[7]);
            qlh = __builtin_bit_cast(bf16x8, hw); qll = __builtin_bit_cast(bf16x8, lw);
        }
        bf16x8 kn0 = *(const GAS bf16x8*)(KI + (size_t)(32 * wave + c) * 32 + 8 * g), kn1 = *(const GAS bf16x8*)(KI + (size_t)(32 * wave + 16 + c) * 32 + 8 * g);
        for (int kp = wave; kp < npair; kp += 8) {
            const bf16x8 k0 = kn0, k1 = kn1;
            { const int kq = kp + 8 < npair ? kp + 8 : kp; kn0 = *(const GAS bf16x8*)(KI + (size_t)(32 * kq + c) * 32 + 8 * g); kn1 = *(const GAS bf16x8*)(KI + (size_t)(32 * kq + 16 + c) * 32 + 8 * g); }
            f32x4 s0 = MFMA16(qlh, k0, ((f32x4){0.f, 0.f, 0.f, 0.f})), s1 = MFMA16(qlh, k1, ((f32x4){0.f, 0.f, 0.f, 0.f}));
            s0 = MFMA16(qll, k0, s0); s1 = MFMA16(qll, k1, s1);
#pragma unroll
            for (int h = 0; h < 8; ++h) {
                const f32x4 l0 = MFMA16(qa[h], k0, ((f32x4){0.f, 0.f, 0.f, 0.f})), l1 = MFMA16(qa[h], k1, ((f32x4){0.f, 0.f, 0.f, 0.f}));
#pragma unroll
                for (int r = 0; r < 4; ++r) { s0[r] = __builtin_fmaf(wq[r][h], __builtin_fabsf(l0[r]), s0[r]); s1[r] = __builtin_fmaf(wq[r][h], __builtin_fabsf(l1[r]), s1[r]); }
            }
#pragma unroll
            for (int r = 0; r < 4; ++r) { SCs[(4 * g + r) * 2048 + 32 * kp + c] = s0[r]; SCs[(4 * g + r) * 2048 + 32 * kp + 16 + c] = s1[r]; }
        }
    }
    __syncthreads();
    unsigned* SELW = (unsigned*)(F.ws + WS_SELW);
    {
        unsigned s0, s1;
        select_top256_x2(SCs + (2 * wave) * 2048, SCs + (2 * wave + 1) * 2048, n, lane, s0, s1);
        SELW[(size_t)(q0 + 2 * wave) * 64 + lane] = s0; SELW[(size_t)(q0 + 2 * wave + 1) * 64 + lane] = s1;
    }
    __syncthreads();
}
template <bool SAMP, bool ISB>
__device__ __forceinline__ void attn_item(Frame& F, const Args& A, int b, int qt, int half) {
    constexpr bool isB = ISB;
    int tid = F.tid; asm volatile("" : "+v"(tid));
    const int lane = tid & 63, wave = __builtin_amdgcn_readfirstlane(tid >> 6), g = lane >> 4, c = lane & 15;
    LAS unsigned char* L = F.lds;
    const int qrow0 = SAMP ? MP + 16 * b : b * T + 64 * qt;
    const int n = isB ? 64 * (qt + 1) : 256;
    LAS unsigned* selw = (LAS unsigned*)(L + AT_MASK);
    if (isB) {
        const v4u* src = (const v4u*)((const unsigned*)(F.ws + WS_SELW) + (size_t)qrow0 * 64);
#pragma unroll
        for (int i = 0; i < 2; ++i) { const v4u w = n > 256 ? src[tid + 512 * i] : (v4u){0xfu, 0xfu, 0xfu, 0xfu}; *(LAS v4u*)(selw + 4 * (tid + 512 * i)) = w; }
    }
    const int hh = wave & 3, qh = wave >> 2;
    const int nq2 = half == 2 ? 2 : 1;
    const int qoff0 = half == 2 ? 32 * qh : 32 * half + 16 * qh;
    const bf16* Qb = (const bf16*)(F.ws + (isB ? WS_QB : WS_QM));
    const bf16* Kb = isB ? (const bf16*)(F.ws + WS_KB) + (size_t)b * T * 256 : (const bf16*)(F.ws + WS_MEMK) + (size_t)b * 256 * 256;
    const bf16* Vb = isB ? (const bf16*)(F.ws + WS_VB) + (size_t)b * T * 256 : (const bf16*)(F.ws + WS_MEMV) + (size_t)b * 256 * 256;
    float bnd = ((const float*)(F.ws + WS_PAR))[isB ? PAR_BNDB : PAR_BNDC];
    const float* Kf = A.in[7] + (size_t)b * 65536; const float* Vf = A.in[8] + (size_t)b * 65536;
    if constexpr (SAMP) {
        float mx = 0.f;
#pragma unroll
        for (int i = 0; i < 4; ++i) {
            const float* kr = Kf + (size_t)((tid >> 3) + 64 * i) * 256 + 32 * (tid & 7);
            float ss = 0.f;
#pragma unroll
            for (int j = 0; j < 8; ++j) { const f32x4 x = *(const GAS f32x4*)(kr + 4 * j); ss += (x[0] * x[0] + x[1] * x[1]) + (x[2] * x[2] + x[3] * x[3]); }
            ss += __shfl_xor(ss, 1);
            mx = fmaxf(mx, ss);
        }
#pragma unroll
        for (int o = 2; o < 64; o <<= 1) mx = fmaxf(mx, __shfl_xor(mx, o));
        if (lane == 0) ((LAS float*)selw)[wave] = mx;
        __syncthreads();
#pragma unroll
        for (int w = 0; w < 8; ++w) mx = fmaxf(mx, ((LAS float*)selw)[w]);
        bnd = 1.01f * 1.4426950408889634f * ((const float*)(F.ws + WS_PAR))[PAR_GQMX] * sqrtf(mx);
    }
    constexpr float SCL = 0.125f * 1.4426950408889634f;
    bf16x8 qf[2][2];
#pragma unroll
    for (int q2 = 0; q2 < 2; ++q2)
#pragma unroll
        for (int ks = 0; ks < 2; ++ks) {
            const v4u qw = *(const GAS v4u*)(Qb + (size_t)(qrow0 + qoff0 + 16 * (q2 < nq2 ? q2 : 0) + c) * 256 + hh * 64 + 32 * ks + 8 * g);
            v4u qs; qs.x = pk2(bflo(qw.x) * SCL, bfhi(qw.x) * SCL); qs.y = pk2(bflo(qw.y) * SCL, bfhi(qw.y) * SCL); qs.z = pk2(bflo(qw.z) * SCL, bfhi(qw.z) * SCL); qs.w = pk2(bflo(qw.w) * SCL, bfhi(qw.w) * SCL);
            qf[q2][ks] = __builtin_bit_cast(bf16x8, qs);
        }
    const bf16x8 ones = __builtin_bit_cast(bf16x8, (v4u){0x3f803f80u, 0x3f803f80u, 0x3f803f80u, 0x3f803f80u});
    const f32x4 nbnd = {-bnd, -bnd, -bnd, -bnd};
    f32x4 lacc[2] = {{0.f, 0.f, 0.f, 0.f}, {0.f, 0.f, 0.f, 0.f}};
    f32x4 ot[2][4];
#pragma unroll
    for (int q2 = 0; q2 < 2; ++q2)
#pragma unroll
        for (int dt = 0; dt < 4; ++dt) ot[q2][dt] = (f32x4){0.f, 0.f, 0.f, 0.f};
    const int nblk = n / 64;
    v4u pk[4], pv[4];
    f32x4 rk[SAMP ? 4 : 1][2], rv[SAMP ? 4 : 1][2];
#define AT_LOAD(blk) do { _Pragma("unroll") for (int i = 0; i < 4; ++i) { const int q = tid + 512 * i, row = q >> 5, c16 = q & 31; \
        if constexpr (SAMP) { const float* kp_ = Kf + (size_t)(64 * (blk) + row) * 256 + 8 * c16; const float* vp_ = Vf + (size_t)(64 * (blk) + row) * 256 + 8 * c16; \
            rk[SAMP ? i : 0][0] = *(const GAS f32x4*)kp_; rk[SAMP ? i : 0][1] = *(const GAS f32x4*)(kp_ + 4); rv[SAMP ? i : 0][0] = *(const GAS f32x4*)vp_; rv[SAMP ? i : 0][1] = *(const GAS f32x4*)(vp_ + 4); } \
        else { pk[i] = *(const GAS v4u*)(Kb + (size_t)(64 * (blk) + row) * 256 + 8 * c16); pv[i] = *(const GAS v4u*)(Vb + (size_t)(64 * (blk) + row) * 256 + 8 * c16); } } } while (0)
#define AT_STORE(buf) do { _Pragma("unroll") for (int i = 0; i < 4; ++i) { const int q = tid + 512 * i, row = q >> 5, c16 = q & 31; \
        if constexpr (SAMP) { pk[i] = pack8(rk[SAMP ? i : 0][0], rk[SAMP ? i : 0][1]); pv[i] = pack8(rv[SAMP ? i : 0][0], rv[SAMP ? i : 0][1]); } \
        *(LAS v4u*)(L + AT_K0 + (buf) * AT_BUF + row * AT_RS + 16 * c16) = pk[i]; *(LAS v4u*)(L + AT_V0 + (buf) * AT_BUF + row * AT_RS + 16 * c16) = pv[i]; } } while (0)
    AT_LOAD(0);
    AT_STORE(0);
    AT_LOAD(nblk > 1 ? 1 : 0);
    __syncthreads();
    for (int kb = 0; kb < nblk; ++kb) {
        const int buf = kb & 1;
        const LAS unsigned char* Kp = L + AT_K0 + buf * AT_BUF; const LAS unsigned char* Vp = L + AT_V0 + buf * AT_BUF;
        if (kb + 1 < nblk) {
            AT_STORE(buf ^ 1);
            AT_LOAD(kb + 2 < nblk ? kb + 2 : kb + 1);
        }
        bf16x8 kf[4][2];
#pragma unroll
        for (int k2 = 0; k2 < 4; ++k2)
#pragma unroll
            for (int ks = 0; ks < 2; ++ks) kf[k2][ks] = lds_frag16(Kp + (16 * k2 + c) * AT_RS + 2 * (hh * 64 + 32 * ks + 8 * g));
        v4u mw[2][4];
#pragma unroll
        for (int q2 = 0; q2 < 2; ++q2)
#pragma unroll
            for (int k2 = 0; k2 < 4; ++k2) mw[q2][k2] = isB ? *(const LAS v4u*)(selw + (qoff0 + 16 * (q2 < nq2 ? q2 : 0) + c) * 64 + 16 * k2 + 4 * g) : (v4u){~0u, ~0u, ~0u, ~0u};
        __builtin_amdgcn_sched_barrier(0);
        f32x4 st[2][4];
#pragma unroll
        for (int q2 = 0; q2 < 2; ++q2) if (q2 < nq2)
#pragma unroll
            for (int k2 = 0; k2 < 4; ++k2) {
                st[q2][k2] = MFMA16(kf[k2][0], qf[q2][0], nbnd);
                st[q2][k2] = MFMA16(kf[k2][1], qf[q2][1], st[q2][k2]);
            }
        __builtin_amdgcn_sched_barrier(0);
        s16x4 vf[4][4];
#pragma unroll
        for (int dt = 0; dt < 4; ++dt) {
            const LAS unsigned char* va = Vp + (4 * g + (c >> 2)) * AT_RS + 2 * (hh * 64 + 16 * dt + 4 * (c & 3));
#pragma unroll
            for (int j = 0; j < 4; ++j) vf[dt][j] = __builtin_bit_cast(s16x4, __builtin_amdgcn_ds_read_tr16_b64_v4i16((LAS v4i16_t*)(va + 16 * j * AT_RS)));
        }
        bf16x8 pb[2][2];
#pragma unroll
        for (int q2 = 0; q2 < 2; ++q2) if (q2 < nq2) {
#pragma unroll
            for (int k2 = 0; k2 < 4; ++k2)
#pragma unroll
                for (int r = 0; r < 4; ++r) {
                    if (ISB) { const unsigned m = (unsigned)__builtin_amdgcn_sbfe((int)mw[q2][k2][r], kb, 1);
                        st[q2][k2][r] = __builtin_bit_cast(float, __builtin_bit_cast(unsigned, fexp2(st[q2][k2][r])) & m); }
                    else st[q2][k2][r] = fexp2(st[q2][k2][r]); }
            pb[q2][0] = acc_to_bfrag(st[q2][0], st[q2][1]); pb[q2][1] = acc_to_bfrag(st[q2][2], st[q2][3]);
        }
        __builtin_amdgcn_sched_barrier(0);
#pragma unroll
        for (int q2 = 0; q2 < 2; ++q2) if (q2 < nq2) { lacc[q2] = MFMA16(ones, pb[q2][0], lacc[q2]); lacc[q2] = MFMA16(ones, pb[q2][1], lacc[q2]); }
#pragma unroll
        for (int dt = 0; dt < 4; ++dt)
#pragma unroll
            for (int q2 = 0; q2 < 2; ++q2) if (q2 < nq2) {
                ot[q2][dt] = MFMA16(cat44(vf[dt][0], vf[dt][1]), pb[q2][0], ot[q2][dt]);
                ot[q2][dt] = MFMA16(cat44(vf[dt][2], vf[dt][3]), pb[q2][1], ot[q2][dt]);
            }
        __builtin_amdgcn_sched_barrier(0);
        __syncthreads();
    }
    const bf16* Zb = (const bf16*)(F.ws + (isB ? WS_ZB : WS_ZM));
    bf16* MIX = (bf16*)(F.ws + WS_MIX);
#pragma unroll
    for (int q2 = 0; q2 < 2; ++q2) if (q2 < nq2 && !(SAMP && qh != 0)) {
        const float inv = 1.0f / lacc[q2][0];
        const size_t row = (size_t)(qrow0 + qoff0 + 16 * q2 + c);
#pragma unroll
        for (int dt = 0; dt < 4; ++dt) {
            const int col = hh * 64 + 16 * dt + 4 * g;
            const v2u z = *(const GAS v2u*)(Zb + row * 256 + col);
            v2u o; o.x = pk2(ot[q2][dt][0] * inv * bflo(z.x), ot[q2][dt][1] * inv * bfhi(z.x)); o.y = pk2(ot[q2][dt][2] * inv * bflo(z.y), ot[q2][dt][3] * inv * bfhi(z.y));
            *(GAS v2u*)(MIX + row * DM + (isB ? 512 : 768) + col) = o;
        }
    }
#undef AT_LOAD
#undef AT_STORE
}

constexpr int SP_SC = 0;
constexpr int SP_Q = 20480;
constexpr int SP_LIST = 24576;
constexpr int SP_COMB = 28672;
constexpr int SP_CBUF = 40960;
__device__ __forceinline__ void sample_gather_attn(Frame& F, int row, const LAS int* list, const float* kold, const float* vold, const float* knew, const float* vnew, int nold,
                                                   const bf16* Qb, const bf16* Zb, int mixcol) {
    int tid = F.tid; asm volatile("" : "+v"(tid));
    const int lane = tid & 63, wave = __builtin_amdgcn_readfirstlane(tid >> 6);
    LAS unsigned char* L = F.lds;
    const v2u qw = *(const GAS v2u*)(Qb + (size_t)row * 256 + 4 * lane);
    const f32x4 q = {bflo(qw.x), bfhi(qw.x), bflo(qw.y), bfhi(qw.y)};
    float m = -1e30f, l = 0.f; f32x4 o = {0.f, 0.f, 0.f, 0.f};
#pragma unroll 1
    for (int i0 = 0; i0 < 32; i0 += 16) {
        f32x4 kv[16], vv[16];
#pragma unroll
        for (int j = 0; j < 16; ++j) { const int s = list[32 * wave + i0 + j];
            const float* kp = s < nold ? kold + (size_t)s * 256 : knew + (size_t)(s - nold) * 256; const float* vp = s < nold ? vold + (size_t)s * 256 : vnew + (size_t)(s - nold) * 256;
            kv[j] = *(const GAS f32x4*)(kp + 4 * lane); vv[j] = *(const GAS f32x4*)(vp + 4 * lane); }
#pragma unroll
        for (int j = 0; j < 16; ++j) {
            float d = (q[0] * kv[j][0] + q[1] * kv[j][1]) + (q[2] * kv[j][2] + q[3] * kv[j][3]);
            d += __builtin_bit_cast(float, __builtin_amdgcn_update_dpp(0, __builtin_bit_cast(int, d), 0x128, 0xf, 0xf, false));
            d += __builtin_bit_cast(float, __builtin_amdgcn_update_dpp(0, __builtin_bit_cast(int, d), 0x124, 0xf, 0xf, false));
            d += __builtin_bit_cast(float, __builtin_amdgcn_update_dpp(0, __builtin_bit_cast(int, d), 0x122, 0xf, 0xf, false));
            d += __builtin_bit_cast(float, __builtin_amdgcn_update_dpp(0, __builtin_bit_cast(int, d), 0x121, 0xf, 0xf, false));
            const float sc_ = d * 0.125f; const float mn = fmaxf(m, sc_), al = expf(m - mn), p = expf(sc_ - mn);
            m = mn; l = l * al + p; o = o * al + vv[j] * p;
        }
    }
    LAS float* comb = (LAS float*)(L + SP_COMB) + wave * 264;
    if ((lane & 15) == 0) { comb[lane >> 4] = m; comb[4 + (lane >> 4)] = l; }
    *(LAS f32x4*)(comb + 8 + 4 * lane) = o;
    __syncthreads();
    if (tid < 256) {
        const int hd = tid >> 6; const LAS float* cb = (const LAS float*)(L + SP_COMB);
        float M = -1e30f;
#pragma unroll
        for (int w = 0; w < 8; ++w) M = fmaxf(M, cb[w * 264 + hd]);
        float Ls = 0.f, O = 0.f;
#pragma unroll
        for (int w = 0; w < 8; ++w) { const float e = expf(cb[w * 264 + hd] - M); Ls += cb[w * 264 + 4 + hd] * e; O += cb[w * 264 + 8 + tid] * e; }
        const float z = bf2f(Zb[(size_t)row * 256 + tid]);
        ((bf16*)(F.ws + WS_MIX))[(size_t)row * DM + mixcol + tid] = (bf16)f2bf(O / Ls * z);
    }
    __syncthreads();
}
constexpr int S4_SC = 0;
constexpr int S4_LIST = 66560;
constexpr int S4_COMB = 70656;
__device__ __forceinline__ void sample_sel_item(Frame& F, const Args& A, int qg) {
    int tid = F.tid; asm volatile("" : "+v"(tid));
    const int lane = tid & 63, wave = __builtin_amdgcn_readfirstlane(tid >> 6), g = lane >> 4, c = lane & 15;
    LAS unsigned char* L = F.lds;
    const int b = qg >> 2, row0 = MP + 4 * qg;
    constexpr int NK = PAST + ST;
    LAS float* SCs = (LAS float*)(L + S4_SC); LAS int* list = (LAS int*)(L + S4_LIST);
    {
        bf16x8 qa[2]; f32x4 wv[2];
#pragma unroll
        for (int p = 0; p < 2; ++p) {
            qa[p] = *(const GAS bf16x8*)((const bf16*)(F.ws + WS_QI) + (size_t)(row0 + 2 * p + (c >> 3)) * 256 + (c & 7) * 32 + 8 * g);
            wv[p] = *(const GAS f32x4*)((const float*)(F.ws + WS_SMALL) + (size_t)(row0 + 2 * p + (g >> 1)) * 16 + 8 + 4 * (g & 1));
        }
        const float* kiold = A.in[6] + (size_t)b * PAST * 32; const float* kinew = F.out + OFF_SKI + (size_t)b * ST * 32;
        constexpr int NT = NK / 16;
        f32x4 nx[4][2];
#pragma unroll
        for (int j = 0; j < 4; ++j) { int kq = wave + 8 * j; kq = kq < NT ? kq : NT - 1; const float* kp = (kq < 256 ? kiold + (size_t)(16 * kq + c) * 32 : kinew + (size_t)c * 32) + 8 * g; nx[j][0] = *(const GAS f32x4*)kp; nx[j][1] = *(const GAS f32x4*)(kp + 4); }
#pragma unroll 1
        for (int kt0 = wave; kt0 < NT; kt0 += 32) {
            f32x4 cu[4][2];
#pragma unroll
            for (int j = 0; j < 4; ++j) { cu[j][0] = nx[j][0]; cu[j][1] = nx[j][1]; }
#pragma unroll
            for (int j = 0; j < 4; ++j) { int kq = kt0 + 32 + 8 * j; kq = kq < NT ? kq : NT - 1; const float* kp = (kq < 256 ? kiold + (size_t)(16 * kq + c) * 32 : kinew + (size_t)c * 32) + 8 * g; nx[j][0] = *(const GAS f32x4*)kp; nx[j][1] = *(const GAS f32x4*)(kp + 4); }
#pragma unroll
            for (int j = 0; j < 4; ++j) {
                const int kt = kt0 + 8 * j;
                const bf16x8 kb = __builtin_bit_cast(bf16x8, pack8(cu[j][0], cu[j][1]));
#pragma unroll
                for (int p = 0; p < 2; ++p) {
                    const f32x4 lg = MFMA16(qa[p], kb, ((f32x4){0.f, 0.f, 0.f, 0.f}));
                    float sc = (wv[p][0] * fmaxf(lg[0], 0.f) + wv[p][1] * fmaxf(lg[1], 0.f)) + (wv[p][2] * fmaxf(lg[2], 0.f) + wv[p][3] * fmaxf(lg[3], 0.f));
                    sc += __shfl_xor(sc, 16);
                    if ((g & 1) == 0 && kt < NT) SCs[(2 * p + (g >> 1)) * 4160 + 16 * kt + c] = sc;
                }
            }
        }
    }
    __syncthreads();
    if (wave < 4) {
        unsigned sl[3];
        select_top256<3, false>(SCs + wave * 4160, NK, lane, sl);
        int base = 0;
#pragma unroll
        for (int w = 0; w < 3; ++w)
#pragma unroll 1
            for (int i = 0; i < 32; ++i) {
                const int e = 32 * w + i; if (e >= 65) break;
                const bool mine = (sl[w] >> i) & 1u;
                const unsigned long long bm = __ballot(mine);
                if (mine) { const int pos = base + (int)__builtin_popcountll(bm & ((1ull << lane) - 1ull)); if (pos < 256) list[wave * 256 + pos] = lane + 64 * e; }
                base += (int)__builtin_popcountll(bm);
            }
    }
    __syncthreads();
    { int* LG = (int*)(F.ws + WS_SLIST) + (size_t)(4 * qg) * 256; LG[tid] = list[tid]; LG[512 + tid] = list[512 + tid]; }
    __syncthreads();
}
__device__ __forceinline__ void sample_bg_item(Frame& F, const Args& A, int qs) {
    const int b = qs >> 4, row = MP + qs;
    LAS int* list = (LAS int*)(F.lds + SP_LIST);
    if (F.tid < 256) list[F.tid] = ((const int*)(F.ws + WS_SLIST))[(size_t)qs * 256 + F.tid];
    __syncthreads();
    sample_gather_attn(F, row, list, A.in[4] + (size_t)b * PAST * 256, A.in[5] + (size_t)b * PAST * 256, F.out + OFF_SK + (size_t)b * ST * 256, F.out + OFF_SV + (size_t)b * ST * 256, PAST,
                       (const bf16*)(F.ws + WS_QB), (const bf16*)(F.ws + WS_ZB), 512);
}

constexpr int Q2_SS = 32, Q2_B1 = 28 * 32;
constexpr int Q2_TOTAL = Q2_SS + Q2_B1;
constexpr int Q_SCAN = 64, Q_B = 256, Q_SB = 128, Q_C = 256, Q_SC = 8, Q_SS = 64, Q_G = 32 * 9;
constexpr int Q_TOTAL = Q_SCAN + Q_B + Q_SB + Q_C + Q_SC + Q_SS + Q_G;
__device__ __forceinline__ void work_phase(Frame& F, const Args& A, int qword, bool second) {
    volatile LAS int* slot = (volatile LAS int*)(F.MISC + 16);
    const int total = second ? Q_TOTAL : Q2_TOTAL;
    const int batch = 1;
    for (int jb = 0, jn = 0;;) {
        if (jn == 0) {
            if (F.tid == 0) slot[0] = (int)__hip_atomic_fetch_add(F.ctl + qword, (unsigned)batch, __ATOMIC_RELAXED, __HIP_MEMORY_SCOPE_AGENT);
            __syncthreads();
            jb = slot[0]; jn = batch;
            __syncthreads();
        }
        int j = jb++; --jn;
        if (j >= total) break;
        int kind, p0 = 0, p1 = 0, p2 = 0; bool flag = false;
        if (!second) {
            if (j < Q2_SS) { kind = 7; p0 = j; }
            else { j -= Q2_SS; kind = 5; p0 = (j & 31) >> 2; p1 = 31 - (j >> 5); p2 = j & 3; }
        } else {
            if (j < Q_SCAN) { kind = 0; p0 = j; flag = false; }
            else if ((j -= Q_SCAN) < Q_SC) { kind = 3; p0 = j; }
            else if ((j -= Q_SC) < Q_B) { kind = 1; p0 = j & 7; p1 = 31 - (j >> 3); flag = true; }
            else if ((j -= Q_B) < Q_SB) { kind = 2; p0 = j; }
            else if ((j -= Q_SB) < Q_SS) { kind = 0; p0 = j; flag = true; }
            else if ((j -= Q_SS) < Q_G) { kind = 4; p0 = j / 9; p1 = j % 9; }
            else { j -= Q_G; kind = 1; p0 = j >> 5; p1 = j & 31; flag = false; }
        }
        if (kind == 0) scan_item(F, A, p0 >> 1, p0 & 1, flag);
        else if (kind == 1) { if (flag) attn_item<false, true>(F, A, p0, p1, 2); else attn_item<false, false>(F, A, p0, p1, 2); }
        else if (kind == 2) sample_bg_item(F, A, p0);
        else if (kind == 3) attn_item<true, false>(F, A, p0, 0, 0);
        else if (kind == 4) gate_item(F, p0, p1);
        else if (kind == 5) b1_item(F, A, p0, p1, p2);
        else sample_sel_item(F, A, p0);
    }
}
__device__ __forceinline__ void p2_phase(Frame& F, const Args& A, int qword = CW_Q1) { work_phase(F, A, qword, false); }
__device__ __forceinline__ void p3_phase(Frame& F, const Args& A, int qword = CW_Q0) { work_phase(F, A, qword, true); }

__global__ void __launch_bounds__(NWAVES * 64, 2) mk_fwd(Args args) {
    extern __shared__ __attribute__((aligned(16))) unsigned char lds[];
    Frame F;
    F.lds = (LAS unsigned char*)lds;
    F.MISC = (volatile LAS unsigned*)(F.lds + MISC_OFF);
    F.tid = threadIdx.x; F.lane = F.tid & 63; F.wave = __builtin_amdgcn_readfirstlane(F.tid >> 6);
    F.G = gridDim.x; { const int bx = blockIdx.x; F.vcu = (F.G % 8 == 0) ? (bx % 8) * (F.G / 8) + bx / 8 : bx; }
    F.out = args.out; F.ws = args.ws; F.ctl = (gu32*)(args.ws + WS_CTL);
    for (int u = F.tid; u < (LDS_BYTES - LDSCTL_OFF) / 4; u += NWAVES * 64) ((LAS unsigned*)(F.lds + LDSCTL_OFF))[u] = 0u;
    __syncthreads();
    XcdBarrier bar; bar.bar = (unsigned*)(F.ctl + CW_BAR) + args.li * XCD_BAR_WORDS; bar.x = 0; bar.st = nullptr;
    if (N_LAUNCHES != PER_PHASE) bar = xcd_barrier_post((unsigned*)(F.ctl + CW_BAR) + args.li * XCD_BAR_WORDS, F.MISC + 8);
#define GRID_BAR(seam) do { if (N_LAUNCHES == PER_PHASE) { if (F.tid == 0) __hip_atomic_store(F.ctl + CW_TMO, 0xBADBA0u | (unsigned)(seam), RLX_AGENT); } else { xcd_barrier(bar); } } while (0)
    const int lo = args.ph_lo, hi = args.ph_hi;
#define IN(k) (lo <= (k) && (k) < hi)
#define BOTH(k) (IN(k) && IN((k) + 1))

    if (IN(0)) { p0_prologue(F, args);
        if (BOTH(0)) GRID_BAR(0); }

    if (IN(1)) {
        pg8::Gemm g{(const bf16*)(F.ws + WS_XN), (const bf16*)(F.ws + WS_WIN), MALL, NALL, DM}; InOrder S; S.init(F.G, (int)blockIdx.x);
        EpiIn E{F.ws, F.out};
        if ((int)blockIdx.x >= 207) {
            small_stage_w(F.ws, F.lds + LDS_MAIN, F.tid);
            __syncthreads();
            for (int it = (int)blockIdx.x - 207; it < 129; it += 49) small_item(F.ws, F.out, F.lds + LDS_MAIN, 128 * it, F.tid);
            __syncthreads();
        }
        pg8::gemm_phase<EpiIn, InOrder, true, true>(F.lds + LDS_MAIN, g, S, E);
        if (BOTH(1)) GRID_BAR(1);

    }

    if (IN(2)) {
        if (blockIdx.x < 16) {
            pg8::Gemm g{(const bf16*)(F.ws + WS_XN), (const bf16*)(F.ws + WS_WIN), MALL, NALL, DM}; MemOrder S{(int)blockIdx.x};
            EpiIn E{F.ws, F.out};
            pg8::gemm_phase<EpiIn, MemOrder, true, true>(F.lds + LDS_MAIN, g, S, E);
            __syncthreads();
        }
        p2_static(F, args);
        p2_phase(F, args);
        if (BOTH(2)) GRID_BAR(2); }

    if (IN(3)) { p3_phase(F, args);
        if (BOTH(3)) GRID_BAR(3); }


    if (IN(5)) {
        pg8::Gemm g{(const bf16*)(F.ws + WS_MIX), (const bf16*)(F.ws + WS_WOUT), MP, DM, DM}; pg8::StaticOrder S; S.init(MP, DM, F.G, (int)blockIdx.x);
        EpiOut E{args.in[0], args.in[1], F.out};
        if (blockIdx.x < 64) sample_out_item(F.ws, args.in[1], F.out, (int)blockIdx.x, F.tid);
        pg8::gemm_phase<EpiOut, pg8::StaticOrder, true, true>(F.lds + LDS_MAIN, g, S, E);
    }
#undef IN
#undef BOTH
}

extern "C" void kernel_launch(void* const* d_in, const int* in_sizes, int n_in, void* d_out, int out_size, void* d_ws, size_t ws_size, hipStream_t stream) {
    static int grid = 0;
    if (grid == 0) {
        if (n_in != 24 || in_sizes[0] != MP * DM || out_size != (int)OUT_TOTAL || ws_size < WS_END) {
            fprintf(stderr, "kernel_launch: unexpected shapes: n_in %d in0 %d out %d ws %zu (need %zu)\n", n_in, n_in > 0 ? in_sizes[0] : -1, out_size, ws_size, (size_t)WS_END); grid = -1; return; }
        int dev = 0, cus = 0, per_cu = 0;
        if (hipGetDevice(&dev) != hipSuccess || hipDeviceGetAttribute(&cus, hipDeviceAttributeMultiprocessorCount, dev) != hipSuccess) { grid = -1; return; }
        if (hipFuncSetAttribute((const void*)mk_fwd, hipFuncAttributeMaxDynamicSharedMemorySize, LDS_BYTES) != hipSuccess) { fprintf(stderr, "kernel_launch: hipFuncSetAttribute failed\n"); grid = -1; return; }
        if (hipOccupancyMaxActiveBlocksPerMultiprocessor(&per_cu, (const void*)mk_fwd, NWAVES * 64, LDS_BYTES) != hipSuccess || per_cu < 1)
            fprintf(stderr, "kernel_launch: note: occupancy query reports %d workgroups per CU\n", per_cu);
        (void)hipGetLastError();
        grid = cus;
    }
    if (grid < 0) return;
    if (hipMemsetAsync((char*)d_ws + WS_CTL, 0, CTL_ZERO_BYTES, stream) != hipSuccess) { fprintf(stderr, "kernel_launch: memset failed\n"); return; }
    Args a{};
    for (int i = 0; i < 24; ++i) a.in[i] = (const float*)d_in[i];
    a.out = (float*)d_out; a.ws = (unsigned char*)d_ws;
    for (int li = 0; li < N_LAUNCHES; ++li) {
        if (N_LAUNCHES == 1) { a.ph_lo = 0; a.ph_hi = PER_PHASE; } else { a.ph_lo = li; a.ph_hi = li + 1; }
        a.li = (N_LAUNCHES == 1) ? 0 : 0;
        hipLaunchKernelGGL(mk_fwd, dim3(grid), dim3(NWAVES * 64), LDS_BYTES, stream, a);
        const hipError_t le = hipPeekAtLastError();
        if (le != hipSuccess) { fprintf(stderr, "kernel_launch: launch %d failed: %s\n", li, hipGetErrorName(le)); break; }
    }
}
```
